# Optimizing an MI355X kernel written in HIP

```python
import jax, jax.numpy as jnp
from jax import lax
import numpy as np

D_MODEL = 1024
BATCH = 8
SEQ = 2048
DEPTH = 4

HEAD_DIM = 64
ROPE_THETA = 10000.0
GM_HEADS = D_MODEL // 2 // HEAD_DIM
GM_CHUNK = 128
NSA_HEADS = D_MODEL // 2 // HEAD_DIM
NSA_KV = NSA_HEADS // 4
NSA_HPG = NSA_HEADS // NSA_KV
CMP_LEN = 32
CMP_STRIDE = 16
SEL_BLOCK = 64
SEL_TOPN = 8
WINDOW = 512
Q_BLOCK = 128
POOL_WIDTH = D_MODEL // 2
POOL_WINDOWS = (2, 4, 8, 16)
POOL_GROUP = POOL_WIDTH // len(POOL_WINDOWS)
S5_WIDTH = D_MODEL // 2
S5_GROUP_CH = 16
S5_GROUPS = S5_WIDTH // S5_GROUP_CH
S5_STATE = 64
FFN_DIM = ((8 * D_MODEL // 3 + 255) // 256) * 256
N_EVEN = (DEPTH + 1) // 2
N_ODD = DEPTH // 2
GM_W = GM_HEADS * HEAD_DIM
NSA_W = NSA_HEADS * HEAD_DIM
KV_W = NSA_KV * HEAD_DIM
EVEN_SPLITS = (GM_W, GM_W, NSA_W, KV_W, KV_W, KV_W, KV_W, KV_W, KV_W, 3 * NSA_HEADS)
EVEN_IN = sum(EVEN_SPLITS)
EVEN_OUT = GM_W + NSA_W
ODD_IN = POOL_WIDTH + S5_WIDTH
ODD_OUT = POOL_WIDTH + S5_WIDTH
RMS_EPS = 1e-6
LN_EPS = 1e-5
NEG_INF = -1e30
SEL_FORCE = 1e4

kernel_name = 'hybrid_gmlp_nsa_pool_s5_macaron'


def rmsnorm(x, g):
    xf = x.astype(jnp.float32)
    y = xf * lax.rsqrt(jnp.mean(xf * xf, axis=-1, keepdims=True) + RMS_EPS)
    return (y * g.astype(jnp.float32)).astype(x.dtype)


def swiglu(h, w_gate, w_up, w_down):
    return (jax.nn.silu(h @ w_gate) * (h @ w_up)) @ w_down


def rope(x, pos):
    half = HEAD_DIM // 2
    inv = ROPE_THETA ** (-jnp.arange(half, dtype=jnp.float32) / half)
    ang = pos[:, None] * inv[None, :]
    cos, sin = jnp.cos(ang)[:, None, :], jnp.sin(ang)[:, None, :]
    xf = x.astype(jnp.float32)
    x1, x2 = xf[..., :half], xf[..., half:]
    return jnp.concatenate([x1 * cos - x2 * sin, x2 * cos + x1 * sin], axis=-1).astype(x.dtype)


def gmlp_spatial_gate(u, v, w_s, b):
    B, S = u.shape[0], u.shape[1]
    u = jax.nn.gelu(u)
    v = jax.nn.gelu(v).astype(jnp.float32)
    mu = jnp.mean(v, axis=-1, keepdims=True)
    var = jnp.mean(jnp.square(v - mu), axis=-1, keepdims=True)
    v = ((v - mu) * lax.rsqrt(var + LN_EPS)).astype(u.dtype)
    causal = jnp.tril(jnp.ones((GM_CHUNK, GM_CHUNK), dtype=w_s.dtype))
    vc = v.reshape(B, S // GM_CHUNK, GM_CHUNK, GM_HEADS, HEAD_DIM)
    s = jnp.einsum('hts,bcshd->bcthd', w_s * causal, vc) + b.T[None, None, :, :, None]
    return u * s.reshape(B, S, GM_HEADS, HEAD_DIM)


def nsa_compress(t, pe, w1, w2, idx):
    B = t.shape[0]
    nc = idx.shape[0]
    blocks = t[:, idx] + pe[:, None, :]
    flat = blocks.transpose(0, 1, 3, 2, 4).reshape(B, nc, NSA_KV, CMP_LEN * HEAD_DIM)
    return jax.nn.gelu(flat @ w1) @ w2


def nsa_attention(q, k_c, v_c, k_s, v_s, k_w, v_w, gate_logits, pe, w1, w2):
    B, S = q.shape[0], q.shape[1]
    G, HPG = NSA_KV, NSA_HPG
    scale = HEAD_DIM ** -0.5
    t = jnp.arange(S, dtype=jnp.int32)
    qg = q.reshape(B, S, G, HPG, HEAD_DIM)

    nc = (S - CMP_LEN) // CMP_STRIDE + 1
    cmp_start = jnp.arange(nc, dtype=jnp.int32) * CMP_STRIDE
    cidx = cmp_start[:, None] + jnp.arange(CMP_LEN, dtype=jnp.int32)[None, :]
    kc = nsa_compress(k_c, pe[0], w1[0], w2[0], cidx)
    vc = nsa_compress(v_c, pe[1], w1[1], w2[1], cidx)
    end_pos = cmp_start + (CMP_LEN - 1)
    kc = rope(kc, end_pos.astype(jnp.float32))
    s_c = jnp.einsum('btgqd,bngd->bgqtn', qg, kc).astype(jnp.float32) * scale
    valid_c = end_pos[None, :] <= t[:, None]
    s_c = jnp.where(valid_c, s_c, NEG_INF)
    p_c = jax.nn.softmax(s_c, axis=-1) * jnp.any(valid_c, axis=-1)[:, None].astype(jnp.float32)
    o_c = jnp.einsum('bgqtn,bngd->btgqd', p_c.astype(vc.dtype), vc)

    nsel = S // SEL_BLOCK
    blk_start = jnp.arange(nsel, dtype=jnp.int32) * SEL_BLOCK
    overlap = ((cmp_start[:, None] < blk_start[None, :] + SEL_BLOCK)
               & (cmp_start[:, None] + CMP_LEN > blk_start[None, :])).astype(jnp.float32)
    imp = jnp.einsum('bgqtn,nj->btgj', p_c, overlap)
    cur = t // SEL_BLOCK
    j = jnp.arange(nsel, dtype=jnp.int32)
    forced = (j[None, :] == 0) | (j[None, :] == cur[:, None]) | (j[None, :] == cur[:, None] - 1)
    causal_blk = blk_start[None, :] <= t[:, None]
    imp = jnp.where(forced[:, None, :], SEL_FORCE,
                    jnp.where(causal_blk[:, None, :], imp, -SEL_FORCE))
    n_top = min(SEL_TOPN, nsel)
    _, sel_idx = lax.top_k(imp, n_top)

    kb = k_s.reshape(B, nsel, SEL_BLOCK, G, HEAD_DIM).transpose(0, 3, 1, 2, 4)
    vb = v_s.reshape(B, nsel, SEL_BLOCK, G, HEAD_DIM).transpose(0, 3, 1, 2, 4)
    nq = S // Q_BLOCK
    q_chunks = qg.reshape(B, nq, Q_BLOCK, G, HPG, HEAD_DIM).transpose(1, 0, 2, 3, 4, 5)
    i_chunks = sel_idx.reshape(B, nq, Q_BLOCK, G, n_top).transpose(1, 0, 2, 3, 4)
    t_chunks = t.reshape(nq, Q_BLOCK)
    bi = jnp.arange(B)[:, None, None, None]
    gi = jnp.arange(G)[None, None, :, None]
    in_blk = jnp.arange(SEL_BLOCK, dtype=jnp.int32)

    def selected_block(args):
        q_i, idx_i, t_i = args
        ks = kb[bi, gi, idx_i]
        vs = vb[bi, gi, idx_i]
        kpos = idx_i[..., None] * SEL_BLOCK + in_blk
        s = jnp.einsum('btgqd,btgnld->btgqnl', q_i, ks).astype(jnp.float32) * scale
        mask = kpos <= t_i[None, :, None, None, None]
        s = jnp.where(mask[:, :, :, None], s, NEG_INF)
        s = s.reshape(B, Q_BLOCK, G, HPG, n_top * SEL_BLOCK)
        p = jax.nn.softmax(s, axis=-1).astype(vs.dtype)
        return jnp.einsum('btgqk,btgkd->btgqd', p, vs.reshape(B, Q_BLOCK, G, n_top * SEL_BLOCK, HEAD_DIM))

    o_s = lax.map(selected_block, (q_chunks, i_chunks, t_chunks))
    o_s = o_s.transpose(1, 0, 2, 3, 4, 5).reshape(B, S, G, HPG, HEAD_DIM)

    span = WINDOW + Q_BLOCK
    kp = jnp.pad(k_w, ((0, 0), (WINDOW, 0), (0, 0), (0, 0)))
    vp = jnp.pad(v_w, ((0, 0), (WINDOW, 0), (0, 0), (0, 0)))
    widx = jnp.arange(nq, dtype=jnp.int32)[:, None] * Q_BLOCK + jnp.arange(span, dtype=jnp.int32)[None, :]
    kw = kp[:, widx]
    vw = vp[:, widx]
    kpos = widx - WINDOW
    qw = qg.reshape(B, nq, Q_BLOCK, G, HPG, HEAD_DIM)
    s_w = jnp.einsum('bitgqd,bikgd->bigqtk', qw, kw).astype(jnp.float32) * scale
    diff = t_chunks[:, :, None] - kpos[:, None, :]
    wmask = (kpos[:, None, :] >= 0) & (diff >= 0) & (diff < WINDOW)
    s_w = jnp.where(wmask[None, :, None, None], s_w, NEG_INF)
    p_w = jax.nn.softmax(s_w, axis=-1).astype(vw.dtype)
    o_w = jnp.einsum('bigqtk,bikgd->bitgqd', p_w, vw).reshape(B, S, G, HPG, HEAD_DIM)

    g = jax.nn.sigmoid(gate_logits.astype(jnp.float32)).reshape(B, S, G, HPG, 3)
    o = g[..., 0:1] * o_c + g[..., 1:2] * o_s + g[..., 2:3] * o_w
    return o.reshape(B, S, NSA_W).astype(q.dtype)


def even_mixer(h, w_in, w_out, gm_w_s, gm_b, cmp_pe, cmp_w1, cmp_w2):
    B, S = h.shape[0], h.shape[1]
    z = h @ w_in
    cuts = list(np.cumsum(EVEN_SPLITS)[:-1])
    u, v, q, kc, vc, ks, vs, kw, vw, gl = jnp.split(z, cuts, axis=-1)
    heads = lambda a, n: a.reshape(B, S, n, HEAD_DIM)
    pos = jnp.arange(S, dtype=jnp.float32)
    out_a = gmlp_spatial_gate(heads(u, GM_HEADS), heads(v, GM_HEADS), gm_w_s, gm_b).reshape(B, S, GM_W)
    out_b = nsa_attention(rope(heads(q, NSA_HEADS), pos),
                          heads(kc, NSA_KV), heads(vc, NSA_KV),
                          rope(heads(ks, NSA_KV), pos), heads(vs, NSA_KV),
                          rope(heads(kw, NSA_KV), pos), heads(vw, NSA_KV),
                          gl, cmp_pe, cmp_w1, cmp_w2)
    return jnp.concatenate([out_a, out_b.astype(out_a.dtype)], axis=-1) @ w_out


def odd_mixer(h, w_in, w_out, pool_w, pool_scale, lam_re, lam_im, b_re, b_im, c_re, c_im, d_skip, log_dt, w_glu):
    B, S = h.shape[0], h.shape[1]
    z = h @ w_in
    zc, zd = z[..., :POOL_WIDTH], z[..., POOL_WIDTH:]
    t = jnp.arange(S, dtype=jnp.int32)

    n_grp = len(POOL_WINDOWS)
    zg = zc.reshape(B, S, n_grp, POOL_GROUP).astype(jnp.float32)
    cs = jnp.concatenate([jnp.zeros((B, 1, n_grp, POOL_GROUP), jnp.float32), jnp.cumsum(zg, axis=1)], axis=1)
    win = jnp.array(POOL_WINDOWS, dtype=jnp.int32)
    lo = jnp.maximum(t[:, None] + 1 - win[None, :], 0)
    lower = cs[:, lo, jnp.arange(n_grp)[None, :]]
    cnt = (t[:, None] + 1 - lo).astype(jnp.float32)
    pooled = (cs[:, 1:] - lower) / cnt[..., None] - zg
    y_c = jnp.einsum('bsgc,gcd->bsgd', pooled, pool_w.astype(jnp.float32))
    y_c = (y_c.reshape(B, S, POOL_WIDTH) * pool_scale.astype(jnp.float32)).astype(h.dtype)

    u = zd.reshape(B, S, S5_GROUPS, S5_GROUP_CH).astype(jnp.float32)
    lam = lax.complex(lam_re.astype(jnp.float32), lam_im.astype(jnp.float32))
    dt = jnp.exp(log_dt.astype(jnp.float32))[:, None]
    lam_bar = jnp.exp(lam * dt)
    b_c = lax.complex(b_re.astype(jnp.float32), b_im.astype(jnp.float32))
    c_c = lax.complex(c_re.astype(jnp.float32), c_im.astype(jnp.float32))
    b_bar = ((lam_bar - 1.0) / lam)[..., None] * b_c
    bu = jnp.einsum('gpc,bsgc->sbgp', b_bar, u.astype(jnp.complex64))
    a = jnp.broadcast_to(lam_bar, (S, 1, S5_GROUPS, S5_STATE))

    def combine(e1, e2):
        a1, b1 = e1
        a2, b2 = e2
        return a2 * a1, a2 * b1 + b2

    _, states = lax.associative_scan(combine, (a, bu), axis=0)
    y = jnp.einsum('gcp,sbgp->bsgc', c_c, states).real + d_skip.astype(jnp.float32) * u
    y = jax.nn.gelu(y.reshape(B, S, S5_WIDTH))
    ab = y @ w_glu.astype(jnp.float32)
    y_d = (ab[..., :S5_WIDTH] * jax.nn.sigmoid(ab[..., S5_WIDTH:])).astype(h.dtype)

    return jnp.concatenate([y_c, y_d], axis=-1) @ w_out


def setup_inputs(seed: int = 0) -> dict:
    key = jax.random.key(seed)
    k = jax.random.split(key, 26)
    f32 = jnp.float32
    nrm = lambda kk, shape, sc: jax.random.normal(kk, shape, f32) * sc
    lam_im = jnp.pi * jnp.broadcast_to(jnp.arange(S5_STATE, dtype=f32), (N_ODD, S5_GROUPS, S5_STATE))
    return {
        'x': nrm(k[0], (BATCH, SEQ, D_MODEL), 1.0),
        'norm_w': 1.0 + nrm(k[1], (DEPTH, 3, D_MODEL), 0.01),
        'ffn_w_gate': nrm(k[2], (DEPTH, 2, D_MODEL, FFN_DIM), D_MODEL ** -0.5),
        'ffn_w_up': nrm(k[3], (DEPTH, 2, D_MODEL, FFN_DIM), D_MODEL ** -0.5),
        'ffn_w_down': nrm(k[4], (DEPTH, 2, FFN_DIM, D_MODEL), FFN_DIM ** -0.5),
        'final_norm_w': 1.0 + nrm(k[5], (D_MODEL,), 0.01),
        'ev_w_in': nrm(k[6], (N_EVEN, D_MODEL, EVEN_IN), D_MODEL ** -0.5),
        'ev_w_out': nrm(k[7], (N_EVEN, EVEN_OUT, D_MODEL), EVEN_OUT ** -0.5),
        'gm_w_s': nrm(k[8], (N_EVEN, GM_HEADS, GM_CHUNK, GM_CHUNK), GM_CHUNK ** -0.5),
        'gm_b': 1.0 + nrm(k[9], (N_EVEN, GM_HEADS, GM_CHUNK), 0.01),
        'nsa_cmp_pe': nrm(k[10], (N_EVEN, 2, CMP_LEN, HEAD_DIM), 0.02),
        'nsa_cmp_w1': nrm(k[11], (N_EVEN, 2, CMP_LEN * HEAD_DIM, HEAD_DIM), (CMP_LEN * HEAD_DIM) ** -0.5),
        'nsa_cmp_w2': nrm(k[12], (N_EVEN, 2, HEAD_DIM, HEAD_DIM), HEAD_DIM ** -0.5),
        'od_w_in': nrm(k[13], (N_ODD, D_MODEL, ODD_IN), D_MODEL ** -0.5),
        'od_w_out': nrm(k[14], (N_ODD, ODD_OUT, D_MODEL), ODD_OUT ** -0.5),
        'pool_w': nrm(k[15], (N_ODD, len(POOL_WINDOWS), POOL_GROUP, POOL_GROUP), POOL_GROUP ** -0.5),
        'pool_scale': 1.0 + nrm(k[16], (N_ODD, POOL_WIDTH), 0.02),
        's5_lam_re': -0.5 + nrm(k[17], (N_ODD, S5_GROUPS, S5_STATE), 0.01),
        's5_lam_im': lam_im + nrm(k[18], (N_ODD, S5_GROUPS, S5_STATE), 0.01),
        's5_b_re': nrm(k[19], (N_ODD, S5_GROUPS, S5_STATE, S5_GROUP_CH), (2 * S5_GROUP_CH) ** -0.5),
        's5_b_im': nrm(k[20], (N_ODD, S5_GROUPS, S5_STATE, S5_GROUP_CH), (2 * S5_GROUP_CH) ** -0.5),
        's5_c_re': nrm(k[21], (N_ODD, S5_GROUPS, S5_GROUP_CH, S5_STATE), (2 * S5_STATE) ** -0.5),
        's5_c_im': nrm(k[22], (N_ODD, S5_GROUPS, S5_GROUP_CH, S5_STATE), (2 * S5_STATE) ** -0.5),
        's5_d': nrm(k[23], (N_ODD, S5_GROUPS, S5_GROUP_CH), 1.0),
        's5_log_dt': jax.random.uniform(k[24], (N_ODD, S5_GROUPS), f32, float(np.log(1e-3)), float(np.log(1e-1))),
        's5_w_glu': nrm(k[25], (N_ODD, S5_WIDTH, 2 * S5_WIDTH), S5_WIDTH ** -0.5),
    }


def reference(x, norm_w, ffn_w_gate, ffn_w_up, ffn_w_down, final_norm_w, ev_w_in, ev_w_out,
              gm_w_s, gm_b, nsa_cmp_pe, nsa_cmp_w1, nsa_cmp_w2, od_w_in, od_w_out, pool_w, pool_scale,
              s5_lam_re, s5_lam_im, s5_b_re, s5_b_im, s5_c_re, s5_c_im, s5_d, s5_log_dt, s5_w_glu):
    for l in range(DEPTH):
        x = x + 0.5 * swiglu(rmsnorm(x, norm_w[l, 0]), ffn_w_gate[l, 0], ffn_w_up[l, 0], ffn_w_down[l, 0])
        h = rmsnorm(x, norm_w[l, 1])
        i = l // 2
        if l % 2 == 0:
            m = even_mixer(h, ev_w_in[i], ev_w_out[i], gm_w_s[i], gm_b[i],
                           nsa_cmp_pe[i], nsa_cmp_w1[i], nsa_cmp_w2[i])
        else:
            m = odd_mixer(h, od_w_in[i], od_w_out[i], pool_w[i], pool_scale[i],
                          s5_lam_re[i], s5_lam_im[i], s5_b_re[i], s5_b_im[i], s5_c_re[i], s5_c_im[i],
                          s5_d[i], s5_log_dt[i], s5_w_glu[i])
        x = x + m.astype(x.dtype)
        x = x + 0.5 * swiglu(rmsnorm(x, norm_w[l, 2]), ffn_w_gate[l, 1], ffn_w_up[l, 1], ffn_w_down[l, 1])
    return rmsnorm(x, final_norm_w)
```

```cpp
#include <hip/hip_runtime.h>
#include <hip/hip_cooperative_groups.h>
#include <cstdio>
namespace cg = cooperative_groups;
__device__ __forceinline__ int otid() { int t = threadIdx.x; asm volatile("" : "+v"(t)); return t; }
__device__ __forceinline__ int obid() { int t = blockIdx.x; asm volatile("" : "+s"(t)); return t; }
__device__ __forceinline__ int ogdim() { int t = gridDim.x; asm volatile("" : "+s"(t)); return t; }
namespace pg8 {
#define PG8_LAS __attribute__((address_space(3)))
typedef unsigned short bf16_t;
typedef short bf16x8 __attribute__((ext_vector_type(8)));
typedef float f32x4 __attribute__((ext_vector_type(4)));
typedef unsigned u32x4 __attribute__((ext_vector_type(4)));
constexpr int BM = 256, BK = 64, HALF = 128, HTB = HALF * BK * 2  , STAGE_BYTES = 8 * HTB, NXCD = 8, WGM = 8;

__host__ __device__ __forceinline__ int lds_byte(int r, int c) { const int st = (r >> 4) * 2 + (c >> 5), rr = r & 15, cc = c & 31, ob = rr * 64 + cc * 2; return st * 1024 + (ob ^ (((ob >> 9) & 1) << 5)); }
__host__ __device__ __forceinline__ void stage_rc(int b, int& R, int& C) { const int st = b / 1024, sb = b % 1024, swz = sb ^ (((sb >> 9) & 1) << 5); R = (st >> 1) * 16 + swz / 64; C = (st & 1) * 32 + (swz % 64) / 2; }
__host__ __device__ __forceinline__ int perm32(int rho) { const int n = rho >> 4, i = rho & 15; return 8 * (i >> 2) + 4 * n + (i & 3); }

struct Unit { int pm, pn; };
struct Gemm { const bf16_t* A; const bf16_t* Bt; int M, N, K; };

struct StaticOrder {
    int nM, nN, nwg, G, c;
    __host__ __device__ void init(int M, int N, int G_, int c_) { nM = M / BM; nN = N / BM; nwg = nM * nN; G = G_; c = c_; }
    __host__ __device__ bool next(int i, Unit& u) const {
        const long L = (long)i * G + c; if (L >= nwg) return false;
        int wgid = (int)L; { const int q = nwg / NXCD, r = nwg % NXCD, xcd = wgid % NXCD, off = wgid / NXCD; wgid = (xcd < r ? xcd * (q + 1) : r * (q + 1) + (xcd - r) * q) + off; }
        const int nig = WGM * nN, gid = wgid / nig, fm = gid * WGM, gsz = (nM - fm) < WGM ? (nM - fm) : WGM;
        u.pm = fm + ((wgid % nig) % gsz); u.pn = (wgid % nig) / gsz; return true;
    }
    __device__ __forceinline__ void a_ready(const Unit&) const {}
    __device__ __forceinline__ void done(const Unit&) const {}
};
__device__ __forceinline__ unsigned cvt_pk_bf16(float lo, float hi) { unsigned r; asm volatile("v_cvt_pk_bf16_f32 %0, %1, %2" : "=v"(r) : "v"(lo), "v"(hi)); return r; }

template <class Epi, class Sched, bool ALIGN_EPI = false, bool SP2 = false>
__device__ __forceinline__ void gemm_phase(PG8_LAS unsigned char* lds, const Gemm g, const Sched& S, const Epi& E) {
    const int tid = otid(), wid = __builtin_amdgcn_readfirstlane(tid >> 6), lane = tid & 63, wr = wid >> 2, wc = wid & 3, fr = lane & 15, fq = lane >> 4;
    const int K = g.K, nt = K / BK;
    unsigned voffA[2], voffB[2];
#pragma unroll
    for (int i = 0; i < 2; ++i) { int R, C; stage_rc(tid * 16 + i * 8192, R, C); const int Rb = Epi::PERM ? ((R & ~31) + perm32(R & 31)) : R;
        voffA[i] = (unsigned)(R * K + C) * 2u; voffB[i] = (unsigned)(Rb * K + C) * 2u; }
    const size_t kstep = (size_t)(BK * 2);
    const size_t hstep = (size_t)HALF * K * 2;
    const size_t tstep = 2 * hstep;
    const unsigned ldsw = (unsigned)wid * 1024u;
    const int aoff = lds_byte(wr * 64 + fr, fq * 8), boff = lds_byte(wc * 32 + fr, fq * 8);
#define PG8_SA(b, h) (((b) * 2 + (h)) * HTB)
#define PG8_SB(b, h) ((4 + (b) * 2 + (h)) * HTB)
#define PG8_STAGE(bufoff, gbase, voff) do { _Pragma("unroll") for (int _i = 0; _i < 2; ++_i) \
        __builtin_amdgcn_global_load_lds((const unsigned*)((const char*)(gbase) + (voff)[_i]), (PG8_LAS unsigned*)(lds + (bufoff) + ldsw + _i * 8192), 16, 0, 0); } while (0)
#define PG8_LDA(dst, b, h) do { _Pragma("unroll") for (int m = 0; m < 4; ++m) _Pragma("unroll") for (int k = 0; k < 2; ++k) dst[m][k] = *(const PG8_LAS bf16x8*)(lds + PG8_SA(b, h) + aoff + m * 2048 + k * 1024); } while (0)
#define PG8_LDB(dst, b, h) do { _Pragma("unroll") for (int n = 0; n < 2; ++n) _Pragma("unroll") for (int k = 0; k < 2; ++k) dst[n][k] = *(const PG8_LAS bf16x8*)(lds + PG8_SB(b, h) + boff + n * 2048 + k * 1024); } while (0)
#define PG8_MMA(ai, bj, At, Bt) do { __builtin_amdgcn_s_setprio(1); _Pragma("unroll") for (int m = 0; m < 4; ++m) _Pragma("unroll") for (int n = 0; n < 2; ++n) _Pragma("unroll") for (int k = 0; k < 2; ++k) \
        acc[ai][bj][m][n] = __builtin_amdgcn_mfma_f32_16x16x32_bf16(Bt[n][k], At[m][k], acc[ai][bj][m][n], 0, 0, 0); __builtin_amdgcn_s_setprio(0); } while (0)
#define PG8_WAIT_V(n) asm volatile("s_waitcnt vmcnt(" #n ")" ::: "memory")
#define PG8_WAIT_L(n) asm volatile("s_waitcnt lgkmcnt(" #n ")" ::: "memory")
#define PG8_BAR __builtin_amdgcn_s_barrier()
#define PG8_SCHED __builtin_amdgcn_sched_barrier(0)
    Unit cur, nxt; int ui = 0;
    if (!S.next(0, cur)) return;
    f32x4 acc[2][2][4][2];
#pragma unroll
    for (int a = 0; a < 2; ++a)
#pragma unroll
        for (int b = 0; b < 2; ++b)
#pragma unroll
            for (int m = 0; m < 4; ++m)
#pragma unroll
                for (int n = 0; n < 2; ++n) acc[a][b][m][n] = (f32x4){0.f, 0.f, 0.f, 0.f};
    bf16x8 At[4][2], B0[2][2], B1[2][2];
    const char* cA = (const char*)g.A + (size_t)cur.pm * tstep; const char* cB = (const char*)g.Bt + (size_t)cur.pn * tstep;
    S.a_ready(cur);
    if constexpr (SP2) {
        PG8_STAGE(PG8_SB(0, 0), cB, voffB); PG8_STAGE(PG8_SB(0, 1), cB + hstep, voffB); PG8_STAGE(PG8_SA(0, 0), cA, voffA); PG8_STAGE(PG8_SA(0, 1), cA + hstep, voffA);
        if (wr == 1) PG8_BAR;
        PG8_WAIT_V(2); PG8_BAR;
        PG8_STAGE(PG8_SB(1, 0), cB + kstep, voffB); PG8_STAGE(PG8_SA(1, 0), cA + kstep, voffA); PG8_STAGE(PG8_SB(1, 1), cB + hstep + kstep, voffB);
        PG8_WAIT_V(6); PG8_BAR;
    } else {
        PG8_STAGE(PG8_SB(0, 0), cB, voffB); PG8_STAGE(PG8_SA(0, 0), cA, voffA); PG8_STAGE(PG8_SB(0, 1), cB + hstep, voffB); PG8_STAGE(PG8_SA(0, 1), cA + hstep, voffA);
        if (wr == 1) PG8_BAR;
        PG8_WAIT_V(4); PG8_BAR;
        PG8_STAGE(PG8_SB(1, 0), cB + kstep, voffB); PG8_STAGE(PG8_SA(1, 0), cA + kstep, voffA); PG8_STAGE(PG8_SB(1, 1), cB + hstep + kstep, voffB);
        PG8_WAIT_V(6); PG8_BAR;
    }
    for (;;) {
        const bool has_next = S.next(ui + 1, nxt);
        const char* nA = has_next ? (const char*)g.A + (size_t)nxt.pm * tstep : cA; const char* nB = has_next ? (const char*)g.Bt + (size_t)nxt.pn * tstep : cB;
        for (int t = 0; t < nt; t += 2) {
            const bool last = (t == nt - 2);
            const char* a1 = cA + (size_t)(t + 1) * kstep;
            const char* a2 = last ? nA : cA + (size_t)(t + 2) * kstep; const char* b2 = last ? nB : cB + (size_t)(t + 2) * kstep;
            const char* a3 = a2 + kstep; const char* b3 = b2 + kstep;
            if (last && has_next) S.a_ready(nxt);
            if constexpr (SP2) {
            PG8_LDB(B0, 0, 0); PG8_LDB(B1, 0, 1); PG8_SCHED; PG8_LDA(At, 0, 0); PG8_STAGE(PG8_SA(1, 1), a1 + hstep, voffA);
            PG8_WAIT_V(8); PG8_WAIT_L(0); PG8_BAR; PG8_MMA(0, 0, At, B0); PG8_MMA(0, 1, At, B1); PG8_BAR; PG8_SCHED;
            PG8_LDA(At, 0, 1); PG8_STAGE(PG8_SB(0, 0), b2, voffB); PG8_STAGE(PG8_SB(0, 1), b2 + hstep, voffB); PG8_STAGE(PG8_SA(0, 0), a2, voffA);
            PG8_WAIT_V(8); PG8_WAIT_L(0); PG8_BAR; PG8_MMA(1, 0, At, B0); PG8_MMA(1, 1, At, B1); PG8_BAR; PG8_SCHED;
            PG8_LDB(B0, 1, 0); PG8_LDB(B1, 1, 1); PG8_SCHED; PG8_LDA(At, 1, 0); PG8_STAGE(PG8_SA(0, 1), a2 + hstep, voffA);
            PG8_WAIT_V(8); PG8_WAIT_L(0); PG8_BAR; PG8_MMA(0, 0, At, B0); PG8_MMA(0, 1, At, B1); PG8_BAR; PG8_SCHED;
            PG8_LDA(At, 1, 1); PG8_STAGE(PG8_SB(1, 0), b3, voffB); PG8_STAGE(PG8_SB(1, 1), b3 + hstep, voffB); PG8_STAGE(PG8_SA(1, 0), a3, voffA);
            PG8_WAIT_V(8); PG8_WAIT_L(0); PG8_BAR; PG8_MMA(1, 0, At, B0); PG8_MMA(1, 1, At, B1); PG8_BAR; PG8_SCHED;
            } else {
            PG8_LDB(B0, 0, 0); PG8_SCHED; PG8_LDA(At, 0, 0); PG8_STAGE(PG8_SA(1, 1), a1 + hstep, voffA);
            PG8_WAIT_L(8); PG8_BAR; PG8_WAIT_L(0); PG8_MMA(0, 0, At, B0); PG8_BAR; PG8_SCHED;
            PG8_LDB(B1, 0, 1); PG8_STAGE(PG8_SB(0, 0), b2, voffB);
            PG8_BAR; PG8_WAIT_L(0); PG8_MMA(0, 1, At, B1); PG8_BAR;
            PG8_LDA(At, 0, 1); PG8_STAGE(PG8_SA(0, 0), a2, voffA);
            PG8_BAR; PG8_WAIT_L(0); PG8_MMA(1, 0, At, B0); PG8_BAR; PG8_SCHED;
            PG8_STAGE(PG8_SB(0, 1), b2 + hstep, voffB);
            PG8_WAIT_V(6); PG8_BAR; PG8_MMA(1, 1, At, B1); PG8_BAR;
            PG8_LDB(B0, 1, 0); PG8_SCHED; PG8_LDA(At, 1, 0); PG8_STAGE(PG8_SA(0, 1), a2 + hstep, voffA);
            PG8_WAIT_L(8); PG8_BAR; PG8_WAIT_L(0); PG8_MMA(0, 0, At, B0); PG8_BAR; PG8_SCHED;
            PG8_LDB(B1, 1, 1); PG8_STAGE(PG8_SB(1, 0), b3, voffB);
            PG8_BAR; PG8_WAIT_L(0); PG8_MMA(0, 1, At, B1); PG8_BAR;
            PG8_LDA(At, 1, 1); PG8_STAGE(PG8_SA(1, 0), a3, voffA);
            PG8_BAR; PG8_WAIT_L(0); PG8_MMA(1, 0, At, B0); PG8_BAR; PG8_SCHED;
            PG8_STAGE(PG8_SB(1, 1), b3 + hstep, voffB);
            PG8_WAIT_V(6); PG8_BAR; PG8_MMA(1, 1, At, B1); PG8_BAR;
            }
        }
        if constexpr (ALIGN_EPI) { if (wr == 0) PG8_BAR; }
        if constexpr (!Epi::AFTER_DRAIN) { E(acc, cur, wr, wc, fr, fq); S.done(cur); }
        if (!has_next) break;
#pragma unroll
        for (int a = 0; a < 2; ++a)
#pragma unroll
            for (int b = 0; b < 2; ++b)
#pragma unroll
                for (int m = 0; m < 4; ++m)
#pragma unroll
                    for (int n = 0; n < 2; ++n) acc[a][b][m][n] = (f32x4){0.f, 0.f, 0.f, 0.f};
        cur = nxt; cA = nA; cB = nB; ++ui;
        if constexpr (ALIGN_EPI) { if (wr == 1) PG8_BAR; }
    }
    PG8_WAIT_V(0);
    if constexpr (!ALIGN_EPI) { if (wr == 0) PG8_BAR; }
    PG8_BAR;
    if constexpr (Epi::AFTER_DRAIN) { E.fused(acc, cur, wr, wc, fr, fq, lds, wid, lane); S.done(cur); }
#undef PG8_SA
#undef PG8_SB
#undef PG8_STAGE
#undef PG8_LDA
#undef PG8_LDB
#undef PG8_MMA
#undef PG8_WAIT_V
#undef PG8_WAIT_L
#undef PG8_BAR
#undef PG8_SCHED
}
}

#define DI __device__ __forceinline__
typedef unsigned short u16;
typedef short bf16x8 __attribute__((ext_vector_type(8)));
typedef short s16x4 __attribute__((ext_vector_type(4)));
typedef float f32x4 __attribute__((ext_vector_type(4)));
typedef float f32x16 __attribute__((ext_vector_type(16)));
typedef unsigned u32x4 __attribute__((ext_vector_type(4)));
typedef unsigned u32x2 __attribute__((ext_vector_type(2)));

constexpr int T = 16384, DM = 1024, FF = 2816, SEQ = 2048, NB = 8;
constexpr int ZW = 2560;
constexpr size_t MiB = 1u << 20;
constexpr size_t OFF_WFFN = 0;
constexpr size_t SZ_WGU = (size_t)5632 * 1024 * 2, SZ_WD = (size_t)1024 * 2816 * 2, SZ_WFFN = SZ_WGU + SZ_WD;
constexpr size_t OFF_WEVIN = 132 * MiB, OFF_WEVOUT = 142 * MiB, OFF_WODIN = 146 * MiB, OFF_WODOUT = 150 * MiB, OFF_WGLU = 154 * MiB;
constexpr size_t OFF_BT1 = 156 * MiB, OFF_FMAT = 172 * MiB, OFF_XB = 180 * MiB, OFF_SS = 212 * MiB, OFF_ROPE = 213 * MiB, OFF_MISC = 214 * MiB;
constexpr size_t OFF_BAR = OFF_MISC + 512 * 1024;
constexpr size_t OFF_UN = 215 * MiB;
constexpr size_t OFF_ACT = OFF_UN, OFF_Z = OFF_UN, OFF_KSR = OFF_UN + 80 * MiB, OFF_KWR = OFF_UN + 84 * MiB, OFF_VST = OFF_UN + 88 * MiB, OFF_VWT = OFF_UN + 92 * MiB;
constexpr size_t OFF_KC = OFF_UN + 96 * MiB, OFF_VCT = OFF_KC + 512 * 1024, OFF_CAT = OFF_UN + 98 * MiB;
constexpr size_t OFF_UD = OFF_UN, OFF_YIN = OFF_UN + 16 * MiB, OFF_E = OFF_UN + 48 * MiB, OFF_ZC = OFF_UN + 64 * MiB;
constexpr size_t OFF_YG = OFF_UN + 80 * MiB;
constexpr size_t OFF_XL = OFF_UN + 130 * MiB;
constexpr size_t OFF_WB16 = OFF_ROPE + 512 * 1024;
constexpr size_t OFF_W1T = OFF_UN + 97 * MiB;
constexpr size_t WS_NEED = OFF_UN + 130 * MiB;
static_assert(8 * SZ_WFFN <= 132 * MiB, "ffn weights");
constexpr int LDS_BYTES = 147456;

struct Prm { const float* in[26]; float* out; unsigned char* ws; };

DI void st16_wt(void* p, u32x4 v) { asm volatile("global_store_dwordx4 %0, %1, off sc1\n\ts_nop 1" :: "v"(p), "v"(v) : "memory"); }
DI void st16f_wt(void* p, f32x4 v) { asm volatile("global_store_dwordx4 %0, %1, off sc1\n\ts_nop 1" :: "v"(p), "v"(v) : "memory"); }
DI void st8_wt(void* p, u32x2 v) { asm volatile("global_store_dwordx2 %0, %1, off sc1\n\ts_nop 1" :: "v"(p), "v"(v) : "memory"); }
DI void st16_pl(void* p, u32x4 v) { *(u32x4*)p = v; }
DI void st16_nt(void* p, u32x4 v) { __builtin_nontemporal_store(v, (u32x4*)p); }
DI void st8_pl(void* p, u32x2 v) { *(u32x2*)p = v; }
DI void st16f_pl(void* p, f32x4 v) { *(f32x4*)p = v; }
DI float bf2f(unsigned v) { return __uint_as_float(v << 16); }
DI unsigned cvtpk(float lo, float hi) { typedef float f2 __attribute__((ext_vector_type(2))); typedef __bf16 b2 __attribute__((ext_vector_type(2))); f2 v = {lo, hi}; b2 b = __builtin_convertvector(v, b2); return __builtin_bit_cast(unsigned, b); }
DI void unpack8(const u32x4 w, float* f) { f[0] = __uint_as_float(w.x << 16); f[1] = __uint_as_float(w.x & 0xffff0000u); f[2] = __uint_as_float(w.y << 16); f[3] = __uint_as_float(w.y & 0xffff0000u);
    f[4] = __uint_as_float(w.z << 16); f[5] = __uint_as_float(w.z & 0xffff0000u); f[6] = __uint_as_float(w.w << 16); f[7] = __uint_as_float(w.w & 0xffff0000u); }
DI u32x4 pack8(const float* f) { u32x4 w; w.x = cvtpk(f[0], f[1]); w.y = cvtpk(f[2], f[3]); w.z = cvtpk(f[4], f[5]); w.w = cvtpk(f[6], f[7]); return w; }
DI float gelu_t(float x) { const float u = 1.5957691216f * (x + 0.044715f * x * x * x); return x * __builtin_amdgcn_rcpf(1.f + __expf(-u)); }
DI float sigm(float x) { return __builtin_amdgcn_rcpf(1.f + __expf(-x)); }
DI float row_rstd(const float* SS, int row) { const f32x4* p = (const f32x4*)(SS + (size_t)row * 16); const f32x4 a = p[0], b = p[1], c = p[2], d = p[3];
    const float s = ((a.x + a.y) + (a.z + a.w)) + ((b.x + b.y) + (b.z + b.w)) + ((c.x + c.y) + (c.z + c.w)) + ((d.x + d.y) + (d.z + d.w)); return rsqrtf(s * (1.f / 1024.f) + 1e-6f); }

using pg8::Unit;
typedef pg8::f32x4 pf4;
template <int MODE> struct EpiGated {
    static constexpr bool PERM = true, AFTER_DRAIN = false;
    u16* O; int ldc; int col_off; const float* SS;
    DI void operator()(const pf4 (&acc)[2][2][4][2], const Unit& u, int wr, int wc, int fr, int fq) const {
#pragma unroll
        for (int ai = 0; ai < 2; ++ai)
#pragma unroll
            for (int m = 0; m < 4; ++m) {
                const int row = u.pm * 256 + ai * 128 + wr * 64 + m * 16 + fr;
                float o[8];
                if (MODE == 0) { const float rs = row_rstd(SS, row);
#pragma unroll
                    for (int n = 0; n < 2; ++n)
#pragma unroll
                        for (int j = 0; j < 4; ++j) { const float g = acc[ai][0][m][n][j] * rs, uu = acc[ai][1][m][n][j] * rs; o[n * 4 + j] = g * sigm(g) * uu; }
                } else {
#pragma unroll
                    for (int n = 0; n < 2; ++n)
#pragma unroll
                        for (int j = 0; j < 4; ++j) { const float a = acc[ai][0][m][n][j], b = acc[ai][1][m][n][j]; o[n * 4 + j] = a * sigm(b); }
                }
                st16_nt(O + (size_t)row * ldc + col_off + u.pn * 128 + wc * 32 + 8 * fq, pack8(o));
            }
    }
};
struct EpiResid {
    static constexpr bool PERM = true, AFTER_DRAIN = false;
    u16* XB; float* SS; float scale;
    DI void operator()(const pf4 (&acc)[2][2][4][2], const Unit& u, int wr, int wc, int fr, int fq) const {
#pragma unroll
        for (int ai = 0; ai < 2; ++ai)
#pragma unroll
            for (int m = 0; m < 4; ++m) {
                const int row = u.pm * 256 + ai * 128 + wr * 64 + m * 16 + fr;
                float sq = 0.f;
#pragma unroll
                for (int bj = 0; bj < 2; ++bj) {
                    const int col = u.pn * 256 + bj * 128 + wc * 32 + 8 * fq;
                    const size_t off = (size_t)row * 1024 + col;
                    float hi[8], o[8], h2[8];
                    unpack8(*(const u32x4*)(XB + off), hi);
#pragma unroll
                    for (int j = 0; j < 4; ++j) { o[j] = hi[j] + scale * acc[ai][bj][m][0][j]; o[4 + j] = hi[4 + j] + scale * acc[ai][bj][m][1][j]; }
                    const u32x4 hp = pack8(o); unpack8(hp, h2);
#pragma unroll
                    for (int j = 0; j < 8; ++j) sq += h2[j] * h2[j];
                    st16_nt(XB + off, hp);
                }
                sq += __shfl_xor(sq, 16); sq += __shfl_xor(sq, 32);
                if (fq == 0) SS[(size_t)row * 16 + u.pn * 4 + wc] = sq;
            }
    }
};
struct EpiEvIn {
    static constexpr bool PERM = true, AFTER_DRAIN = false;
    u16* Z; const float* SS;
    DI void operator()(const pf4 (&acc)[2][2][4][2], const Unit& u, int wr, int wc, int fr, int fq) const {
#pragma unroll
        for (int ai = 0; ai < 2; ++ai)
#pragma unroll
            for (int m = 0; m < 4; ++m) {
                const int row = u.pm * 256 + ai * 128 + wr * 64 + m * 16 + fr; const float rs = row_rstd(SS, row);
#pragma unroll
                for (int bj = 0; bj < 2; ++bj) { float o[8];
#pragma unroll
                    for (int j = 0; j < 4; ++j) { o[j] = acc[ai][bj][m][0][j] * rs; o[4 + j] = acc[ai][bj][m][1][j] * rs; }
                    st16_nt(Z + (size_t)row * ZW + u.pn * 256 + bj * 128 + wc * 32 + 8 * fq, pack8(o)); }
            }
    }
};
struct EpiOdIn {
    static constexpr bool PERM = true, AFTER_DRAIN = false;
    u16* ZC; u16* UD; const float* SS;
    DI void operator()(const pf4 (&acc)[2][2][4][2], const Unit& u, int wr, int wc, int fr, int fq) const {
#pragma unroll
        for (int ai = 0; ai < 2; ++ai)
#pragma unroll
            for (int m = 0; m < 4; ++m) {
                const int row = u.pm * 256 + ai * 128 + wr * 64 + m * 16 + fr; const float rs = row_rstd(SS, row);
#pragma unroll
                for (int bj = 0; bj < 2; ++bj) { float o[8];
#pragma unroll
                    for (int j = 0; j < 4; ++j) { o[j] = acc[ai][bj][m][0][j] * rs; o[4 + j] = acc[ai][bj][m][1][j] * rs; }
                    const int col = u.pn * 256 + bj * 128 + wc * 32 + 8 * fq;
                    if (u.pn < 2) st16_pl(ZC + (size_t)row * 512 + col, pack8(o));
                    else { const int c2 = col - 512, g = c2 >> 4, ci = c2 & 15; st16_pl(UD + ((size_t)(g * 1024 + (row >> 4)) * 256 + (row & 15) * 16 + ci), pack8(o)); } }
            }
    }
};
struct EpiS5A {
    static constexpr bool PERM = true, AFTER_DRAIN = false;
    float* YIN; float* E;
    DI void operator()(const pf4 (&acc)[2][2][4][2], const Unit& u, int wr, int wc, int fr_, int fq_) const {
        int fr = fr_, fq = fq_; asm volatile("" : "+v"(fr), "+v"(fq));
        const int g = u.pm >> 2, pml = u.pm & 3, pnl = u.pn & 1;
        float* base = pnl == 0 ? YIN + (size_t)g * 1024 * 256 : E + (size_t)g * 1024 * 128; const int ld = pnl == 0 ? 256 : 128; const int nbj = pnl == 0 ? 2 : 1;
#pragma unroll
        for (int ai = 0; ai < 2; ++ai)
#pragma unroll
            for (int m = 0; m < 4; ++m) {
                const int rowl = pml * 256 + ai * 128 + wr * 64 + m * 16 + fr;
#pragma unroll
                for (int bj = 0; bj < 2; ++bj) if (bj < nbj) { float* p = base + (size_t)rowl * ld + bj * 128 + wc * 32 + 8 * fq; st16f_pl(p, acc[ai][bj][m][0]); st16f_pl(p + 4, acc[ai][bj][m][1]); }
            }
    }
};
struct EpiS5B {
    static constexpr bool PERM = true, AFTER_DRAIN = false;
    const float* YIN; u16* YG;
    DI void operator()(const pf4 (&acc)[2][2][4][2], const Unit& u, int wr, int wc, int fr, int fq) const {
        const int g = u.pm >> 2, pml = u.pm & 3;
#pragma unroll
        for (int ai = 0; ai < 2; ++ai)
#pragma unroll
            for (int m = 0; m < 4; ++m) {
                const int rowl = pml * 256 + ai * 128 + wr * 64 + m * 16 + fr;
#pragma unroll
                for (int bj = 0; bj < 2; ++bj) { const int col = bj * 128 + wc * 32 + 8 * fq;
                    const float* yp = YIN + (size_t)(g * 1024 + rowl) * 256 + col; const f32x4 a = *(const f32x4*)yp, b = *(const f32x4*)(yp + 4); float o[8];
#pragma unroll
                    for (int j = 0; j < 4; ++j) { o[j] = gelu_t(a[j] + acc[ai][bj][m][0][j]); o[4 + j] = gelu_t(b[j] + acc[ai][bj][m][1][j]); }
                    const int token = rowl * 16 + (col >> 4);
                    st16_pl(YG + (size_t)token * 512 + g * 16 + (col & 15), pack8(o)); }
            }
    }
};
struct S5FA { int L;
    DI bool next(int i, Unit& u) const { if (i >= 2) return false; u.pm = L; u.pn = (L >> 2) * 2 + i; return true; }
    DI void a_ready(const Unit&) const {} DI void done(const Unit&) const {} };
struct S5FB { int L;
    DI bool next(int i, Unit& u) const { if (i >= 1) return false; u.pm = L; u.pn = L >> 2; return true; }
    DI void a_ready(const Unit&) const {} DI void done(const Unit&) const {} };
struct S5AOrder { int G, c;
    DI bool next(int i, Unit& u) const { const int L = i * G + c; if (L >= 256) return false; const int g = L >> 3, r = L & 7; u.pm = g * 4 + (r >> 1); u.pn = g * 2 + (r & 1); return true; }
    DI void a_ready(const Unit&) const {} DI void done(const Unit&) const {} };
struct S5BOrder { int G, c;
    DI bool next(int i, Unit& u) const { const int L = i * G + c; if (L >= 128) return false; u.pm = L; u.pn = L >> 2; return true; }
    DI void a_ready(const Unit&) const {} DI void done(const Unit&) const {} };

struct TJob { const float* W; int ldw, K, N, Nvalid; const float* gain; u16* dst; int blk, stride, off; };

DI void tile_writeout(const TJob& J, const float* tile, int k0, int n0) {
    const int tid = otid(), n = tid >> 3, kc = (tid & 7) * 8;
    float v[8];
#pragma unroll
    for (int j = 0; j < 8; ++j) v[j] = tile[(kc + j) * 65 + n];
    const int nn = n0 + n; const int drow = (nn / J.blk) * J.stride + (nn % J.blk) + J.off;
    st16_pl(J.dst + (size_t)drow * J.K + k0 + kc, pack8(v));
}
DI void tjob_run(const TJob& J, float* tile, int vb, int G) {
    const int tid = otid(), tk = J.K / 64, tn = J.N / 64, nt = tk * tn;
    const int kk = tid >> 4, nn = (tid & 15) * 4;
    for (int it0 = vb; it0 < nt; it0 += 8 * G) {
        f32x4 v[8][2];
#pragma unroll
        for (int q = 0; q < 8; ++q) { const int it = it0 + q * G; const int k0 = (it % tk) * 64, n0 = (it / tk) * 64;
#pragma unroll
            for (int i = 0; i < 2; ++i) { v[q][i] = (f32x4){0.f, 0.f, 0.f, 0.f};
                if (it < nt && n0 + nn < J.Nvalid) v[q][i] = __builtin_nontemporal_load((const f32x4*)(J.W + (size_t)(k0 + kk + 32 * i) * J.ldw + n0 + nn)); } }
#pragma unroll
        for (int q = 0; q < 8; ++q) { const int it = it0 + q * G; const int k0 = (it % tk) * 64;
#pragma unroll
            for (int i = 0; i < 2; ++i) { const float gn = (J.gain && it < nt) ? J.gain[k0 + kk + 32 * i] : 1.f; float* tp = tile + q * (64 * 65) + (kk + 32 * i) * 65 + nn;
                tp[0] = v[q][i].x * gn; tp[1] = v[q][i].y * gn; tp[2] = v[q][i].z * gn; tp[3] = v[q][i].w * gn; } }
        __syncthreads();
#pragma unroll
        for (int q = 0; q < 8; ++q) { const int it = it0 + q * G; if (it < nt) tile_writeout(J, tile + q * (64 * 65), (it % tk) * 64, (it / tk) * 64); }
        __syncthreads();
    }
}
DI void pool_fold_run(const float* Win, const float* Wp, const float* scale, const float* gain, u16* dst, float* tile, int vb, int G) {
    const int tid = otid(); TJob J{nullptr, 0, 1024, 512, 512, nullptr, dst, 512, 0, 0};
    for (int it = vb; it < 16 * 8; it += G) {
        const int k0 = (it & 15) * 64, n0 = (it >> 4) * 64, grp = n0 >> 7, n = tid & 63, kq = tid >> 6;
        float acc[8];
#pragma unroll
        for (int j = 0; j < 8; ++j) acc[j] = 0.f;
        const float* wp = Wp + (size_t)grp * 128 * 128 + ((n0 & 127) + n);
        for (int c = 0; c < 128; ++c) { const float w = wp[(size_t)c * 128];
#pragma unroll
            for (int j = 0; j < 8; ++j) acc[j] += Win[(size_t)(k0 + kq * 8 + j) * 1024 + grp * 128 + c] * w; }
        const float sc = scale[n0 + n];
#pragma unroll
        for (int j = 0; j < 8; ++j) tile[(kq * 8 + j) * 65 + n] = acc[j] * sc * gain[k0 + kq * 8 + j];
        __syncthreads();
        tile_writeout(J, tile, k0, n0);
        __syncthreads();
    }
}

DI void s5_tables_item(const Prm& P, int i, int g, float* lds) {
    float* BB = lds;
    float* CC = lds + 2048;
    float* PW = lds + 4096;
    float* KL = lds + 6400;
    const int tid = otid(), ig = i * 32 + g;
    u16* BT1 = (u16*)(P.ws + OFF_BT1) + (size_t)ig * 512 * 256;
    u16* FM = (u16*)(P.ws + OFF_FMAT) + (size_t)ig * 256 * 256;
    float* LAML = (float*)(P.ws + OFF_MISC) + 4096 + (size_t)ig * 128;
    if (tid < 64) { const int p = tid;
        const float lr0 = P.in[17][ig * 64 + p], li0 = P.in[18][ig * 64 + p], dt = __expf(P.in[24][ig]);
        const float a = lr0 * dt, bb = li0 * dt * 0.15915494309189535f;
        for (int tau = 0; tau <= 16; ++tau) { const float mag = __expf(a * tau); float rev = bb * tau; rev -= rintf(rev); const float ang = rev * 6.283185307179586f;
            PW[(tau * 64 + p) * 2] = mag * cosf(ang); PW[(tau * 64 + p) * 2 + 1] = mag * sinf(ang); }
        const float nr = PW[(64 + p) * 2] - 1.f, ni = PW[(64 + p) * 2 + 1], den = 1.f / (lr0 * lr0 + li0 * li0);
        const float cr = (nr * lr0 + ni * li0) * den, ci_ = (ni * lr0 - nr * li0) * den;
        for (int ci = 0; ci < 16; ++ci) { const float br = P.in[19][(ig * 64 + p) * 16 + ci], bi = P.in[20][(ig * 64 + p) * 16 + ci];
            BB[(p * 16 + ci) * 2] = cr * br - ci_ * bi; BB[(p * 16 + ci) * 2 + 1] = cr * bi + ci_ * br; }
        LAML[p * 2] = PW[(16 * 64 + p) * 2]; LAML[p * 2 + 1] = PW[(16 * 64 + p) * 2 + 1];
    }
    for (int e = tid; e < 1024; e += 512) { CC[e * 2] = P.in[21][ig * 1024 + e]; CC[e * 2 + 1] = P.in[22][ig * 1024 + e]; }
    __syncthreads();
    for (int e = tid; e < 4096; e += 512) { const int tau = e >> 8, co = (e >> 4) & 15, ci = e & 15; float s = 0.f;
        for (int p = 0; p < 64; ++p) { const float c_r = CC[(co * 64 + p) * 2], c_i = CC[(co * 64 + p) * 2 + 1], w_r = PW[(tau * 64 + p) * 2], w_i = PW[(tau * 64 + p) * 2 + 1];
            const float x_r = c_r * w_r - c_i * w_i, x_i = c_r * w_i + c_i * w_r; s += x_r * BB[(p * 16 + ci) * 2] - x_i * BB[(p * 16 + ci) * 2 + 1]; }
        if (tau == 0 && co == ci) s += P.in[23][ig * 16 + co];
        KL[e] = s; }
    __syncthreads();
    for (int q = tid; q < 256 * 32; q += 512) { const int row = q >> 5, cc = (q & 31) * 8, t = row >> 4, co = row & 15, s = cc >> 4, ci0 = cc & 15, tau = t - s; float v[8];
#pragma unroll
        for (int j = 0; j < 8; ++j) v[j] = tau >= 0 ? KL[(tau * 16 + co) * 16 + ci0 + j] : 0.f;
        *(u32x4*)(BT1 + (size_t)row * 256 + cc) = pack8(v); }
    for (int q = tid; q < 256 * 32; q += 512) { const int row2 = q >> 5, cc = (q & 31) * 8; float v[8];
        if (row2 < 128) { const int c = row2 >> 6, p = row2 & 63, s = cc >> 4, ci0 = cc & 15; const float w_r = PW[((15 - s) * 64 + p) * 2], w_i = PW[((15 - s) * 64 + p) * 2 + 1];
#pragma unroll
            for (int j = 0; j < 8; ++j) { const float b_r = BB[(p * 16 + ci0 + j) * 2], b_i = BB[(p * 16 + ci0 + j) * 2 + 1]; v[j] = c ? (w_r * b_i + w_i * b_r) : (w_r * b_r - w_i * b_i); }
        } else {
#pragma unroll
            for (int j = 0; j < 8; ++j) v[j] = 0.f; }
        *(u32x4*)(BT1 + (size_t)(256 + row2) * 256 + cc) = pack8(v); }
    for (int q = tid; q < 256 * 32; q += 512) { const int row = q >> 5, cc = (q & 31) * 8, t = row >> 4, co = row & 15; float v[8];
#pragma unroll
        for (int j = 0; j < 8; ++j) { const int k = cc + j; if (k < 128) { const int p = k & 63; const float c_r = CC[(co * 64 + p) * 2], c_i = CC[(co * 64 + p) * 2 + 1], w_r = PW[((t + 1) * 64 + p) * 2], w_i = PW[((t + 1) * 64 + p) * 2 + 1];
                v[j] = (k < 64) ? (c_r * w_r - c_i * w_i) : -(c_r * w_i + c_i * w_r); } else v[j] = 0.f; }
        *(u32x4*)(FM + (size_t)row * 256 + cc) = pack8(v); }
    __syncthreads();
}

DI void convert_layer_part(const Prm& P, int l, int part, int vb, int G, float* tile) {
    unsigned char* ws = P.ws; const int lj = l * 2 + part, i = l >> 1;
    { const float* gain = P.in[1] + (size_t)(l * 3 + (part ? 2 : 0)) * 1024;
      u16* gu = (u16*)(ws + OFF_WFFN + (size_t)lj * SZ_WFFN); u16* dn = (u16*)(ws + OFF_WFFN + (size_t)lj * SZ_WFFN + SZ_WGU);
      TJob a{P.in[2] + (size_t)lj * 1024 * FF, FF, 1024, FF, FF, gain, gu, 128, 256, 0}; tjob_run(a, tile, vb, G);
      TJob b{P.in[3] + (size_t)lj * 1024 * FF, FF, 1024, FF, FF, gain, gu, 128, 256, 128}; tjob_run(b, tile, vb, G);
      TJob c{P.in[4] + (size_t)lj * FF * 1024, 1024, FF, 1024, 1024, nullptr, dn, 1024, 0, 0}; tjob_run(c, tile, vb, G); }
    const float* g_mx = P.in[1] + (size_t)(l * 3 + 1) * 1024;
    if (!(l & 1)) {
        if (part == 0) { TJob a{P.in[6] + (size_t)i * 1024 * 2328, 2328, 1024, ZW, 2328, g_mx, (u16*)(ws + OFF_WEVIN) + (size_t)i * ZW * 1024, ZW, 0, 0}; tjob_run(a, tile, vb, G); }
        else { TJob b{P.in[7] + (size_t)i * 1024 * 1024, 1024, 1024, 1024, 1024, nullptr, (u16*)(ws + OFF_WEVOUT) + (size_t)i * 1024 * 1024, 1024, 0, 0}; tjob_run(b, tile, vb, G); }
    } else {
        u16* odin = (u16*)(ws + OFF_WODIN) + (size_t)i * 1024 * 1024;
        if (part == 0) { TJob c{P.in[13] + (size_t)i * 1024 * 1024 + 512, 1024, 1024, 512, 512, g_mx, odin + (size_t)512 * 1024, 512, 0, 0}; tjob_run(c, tile, vb, G);
            pool_fold_run(P.in[13] + (size_t)i * 1024 * 1024, P.in[15] + (size_t)i * 4 * 128 * 128, P.in[16] + i * 512, g_mx, odin, tile, vb, G); }
        else { TJob d{P.in[14] + (size_t)i * 1024 * 1024, 1024, 1024, 1024, 1024, nullptr, (u16*)(ws + OFF_WODOUT) + (size_t)i * 1024 * 1024, 1024, 0, 0}; tjob_run(d, tile, vb, G);
            u16* glu = (u16*)(ws + OFF_WGLU) + (size_t)i * 1024 * 512;
            TJob e{P.in[25] + (size_t)i * 512 * 1024, 1024, 512, 512, 512, nullptr, glu, 128, 256, 0}; tjob_run(e, tile, vb, G);
            TJob f{P.in[25] + (size_t)i * 512 * 1024 + 512, 1024, 512, 512, 512, nullptr, glu, 128, 256, 128}; tjob_run(f, tile, vb, G); }
    }
}
DI void phase_prep(const Prm& P, unsigned char* ldsb) {
    float* tile = (float*)ldsb; const int tid = otid(), lane = tid & 63, wave = tid >> 6;
    unsigned char* ws = P.ws;
    for (int ll = 0; ll < 4; ++ll) { convert_layer_part(P, ll, 0, obid(), ogdim(), tile); convert_layer_part(P, ll, 1, obid(), ogdim(), tile); }
    { u16* WB = (u16*)(ws + OFF_WB16);
      for (int e = (obid() * 512 + tid) * 2; e < 2 * 8 * 128 * 128; e += ogdim() * 1024) { const int t = (e >> 7) & 127, s = e & 127; const float a = P.in[8][e], b2 = P.in[8][e + 1];
          *(unsigned*)(WB + e) = cvtpk(s <= t ? a : 0.f, (s + 1) <= t ? b2 : 0.f); } }
    for (int it = 0; it < 4; ++it) { TJob a{P.in[11] + (size_t)it * 2048 * 64, 64, 2048, 64, 64, nullptr, (u16*)(ws + OFF_W1T) + (size_t)it * 64 * 2048, 64, 0, 0}; tjob_run(a, tile, obid(), ogdim()); }
    for (int it = obid(); it < 64; it += ogdim()) s5_tables_item(P, it >> 5, it & 31, tile);
    for (int it = obid(); it < 4; it += ogdim()) {
        const float* pe = P.in[10] + (size_t)it * 2048; const float* w1 = P.in[11] + (size_t)it * 2048 * 64; const int j = tid & 63, part = tid >> 6; float s = 0.f;
        for (int k = part * 256; k < part * 256 + 256; ++k) s += pe[k] * w1[(size_t)k * 64 + j];
        tile[part * 64 + j] = s; __syncthreads();
        if (tid < 64) { float t2 = 0.f; for (int q = 0; q < 8; ++q) t2 += tile[q * 64 + tid]; ((float*)(ws + OFF_MISC))[it * 64 + tid] = t2; }
        __syncthreads();
    }
    { float* COS = (float*)(ws + OFF_ROPE); float* SIN = COS + 2048 * 32;
      for (int e = obid() * 512 + tid; e < 2048 * 32; e += ogdim() * 512) { const int t = e >> 5, i = e & 31; const float inv = exp2f(-(float)i * (13.287712379549449f / 32.f)); const float ang = (float)t * inv; COS[e] = cosf(ang); SIN[e] = sinf(ang); } }
    { const float* x = P.in[0]; u16* XB = (u16*)(ws + OFF_XB); float* SS = (float*)(ws + OFF_SS);
      for (int row = obid() * 8 + wave; row < T; row += ogdim() * 8) { float sq = 0.f;
#pragma unroll
          for (int i = 0; i < 2; ++i) { const int col = lane * 8 + 512 * i; const size_t off = (size_t)row * 1024 + col; float v[8], h2[8];
              const f32x4 a = *(const f32x4*)(x + off), b2 = *(const f32x4*)(x + off + 4);
              v[0] = a.x; v[1] = a.y; v[2] = a.z; v[3] = a.w; v[4] = b2.x; v[5] = b2.y; v[6] = b2.z; v[7] = b2.w;
              const u32x4 hp = pack8(v); unpack8(hp, h2);
#pragma unroll
              for (int j = 0; j < 8; ++j) sq += h2[j] * h2[j];
              st16_pl(XB + off, hp); }
#pragma unroll
          for (int o = 32; o >= 1; o >>= 1) sq += __shfl_xor(sq, o);
          if (lane < 16) SS[(size_t)row * 16 + lane] = lane == 0 ? sq : 0.f; } }
}

#define MFMA32E(a, b, c) __builtin_amdgcn_mfma_f32_32x32x16_bf16((a), (b), (c), 0, 0, 0)
DI void gmlp_item(const Prm& P, int i, int item, unsigned char* ldsb) {
    u16* VT = (u16*)ldsb;
    const int tid = otid(), h = item & 7, bc = item >> 3, token0 = bc * 128;
    const u16* Z = (const u16*)(P.ws + OFF_Z); u16* CAT = (u16*)(P.ws + OFF_CAT);
    { const int tok = tid >> 2, part = tid & 3; const u16* vp = Z + (size_t)(token0 + tok) * ZW + 512 + h * 64 + part * 16;
      float v[16]; unpack8(*(const u32x4*)vp, v); unpack8(*(const u32x4*)(vp + 8), v + 8);
      float s = 0.f;
#pragma unroll
      for (int j = 0; j < 16; ++j) { v[j] = gelu_t(v[j]); s += v[j]; }
      s += __shfl_xor(s, 1); s += __shfl_xor(s, 2); const float mu = s * (1.f / 64.f); float q = 0.f;
#pragma unroll
      for (int j = 0; j < 16; ++j) { v[j] -= mu; q += v[j] * v[j]; }
      q += __shfl_xor(q, 1); q += __shfl_xor(q, 2); const float rs = rsqrtf(q * (1.f / 64.f) + 1e-5f);
#pragma unroll
      for (int j = 0; j < 16; j += 2) { const unsigned w = cvtpk(v[j] * rs, v[j + 1] * rs); VT[(part * 16 + j) * 136 + tok] = (u16)(w & 0xffffu); VT[(part * 16 + j + 1) * 136 + tok] = (u16)(w >> 16); } }
    __syncthreads();
    { const int wv = tid >> 6, lane = tid & 63, r = lane & 31, hh = lane >> 5, db = wv & 1, tb = wv >> 1;
      const u16* WB = (const u16*)(P.ws + OFF_WB16) + ((size_t)(i * 8 + h) * 128 + 32 * tb + r) * 128 + 8 * hh;
      const u16* va = VT + (32 * db + r) * 136 + 8 * hh;
      f32x16 acc;
#pragma unroll
      for (int e = 0; e < 16; ++e) acc[e] = 0.f;
#pragma unroll
      for (int ks = 0; ks < 8; ++ks) if (ks <= 2 * tb + 1) { const bf16x8 a = *(const bf16x8*)(va + 16 * ks); const bf16x8 b2 = *(const bf16x8*)(WB + 16 * ks); acc = MFMA32E(a, b2, acc); }
      const int t = 32 * tb + r, token = token0 + t; const float bias = P.in[9][(i * 8 + h) * 128 + t];
#pragma unroll
      for (int gi = 0; gi < 4; ++gi) { const int d0 = 32 * db + 8 * gi + 4 * hh; const u32x2 uu = *(const u32x2*)(Z + (size_t)token * ZW + h * 64 + d0);
          const float u0 = gelu_t(bf2f(uu.x & 0xffffu)) * (acc[gi * 4] + bias), u1 = gelu_t(bf2f(uu.x >> 16)) * (acc[gi * 4 + 1] + bias), u2 = gelu_t(bf2f(uu.y & 0xffffu)) * (acc[gi * 4 + 2] + bias), u3 = gelu_t(bf2f(uu.y >> 16)) * (acc[gi * 4 + 3] + bias);
          u32x2 o; o.x = cvtpk(u0, u1); o.y = cvtpk(u2, u3); st8_pl(CAT + (size_t)token * 1024 + h * 64 + d0, o); } }
    __syncthreads();
}
DI void cmp_item(const Prm& P, int i, int item, float* lds) {
    float* PART = lds;
    float* HB = lds + 8 * 32 * 64;
    float* OB = HB + 32 * 64;
    const int tid = otid(), wv = tid >> 6, lane = tid & 63, r = lane & 31, hh = lane >> 5;
    const int nt = item & 3, g = (item >> 2) & 1, b = (item >> 3) & 7, kv = item >> 6;
    const u16* Z = (const u16*)(P.ws + OFF_Z);
    const int col0 = (kv ? 1664 : 1536) + g * 64, n_a = nt * 32 + r;
    const u16* w1t = (const u16*)(P.ws + OFF_W1T) + (size_t)(i * 2 + kv) * 64 * 2048;
    f32x16 acc0, acc1;
#pragma unroll
    for (int e = 0; e < 16; ++e) { acc0[e] = 0.f; acc1[e] = 0.f; }
#pragma unroll 4
    for (int q = 0; q < 16; ++q) { const int ks = wv * 16 + q, l = ks >> 2, d = 16 * (ks & 3) + 8 * hh, pos = 16 * n_a + l;
        bf16x8 a = (bf16x8){0, 0, 0, 0, 0, 0, 0, 0};
        if (n_a < 127 && pos < SEQ) a = *(const bf16x8*)(Z + (size_t)(b * SEQ + pos) * ZW + col0 + d);
        const bf16x8 b0 = *(const bf16x8*)(w1t + (size_t)r * 2048 + 16 * ks + 8 * hh), b1 = *(const bf16x8*)(w1t + (size_t)(32 + r) * 2048 + 16 * ks + 8 * hh);
        acc0 = MFMA32E(a, b0, acc0); acc1 = MFMA32E(a, b1, acc1); }
#pragma unroll
    for (int e = 0; e < 16; ++e) { const int nl = (e & 3) + 8 * (e >> 2) + 4 * hh; PART[(wv * 32 + nl) * 64 + r] = acc0[e]; PART[(wv * 32 + nl) * 64 + 32 + r] = acc1[e]; }
    __syncthreads();
    const int j = tid & 63, nq = tid >> 6;
    { const float cpe = ((const float*)(P.ws + OFF_MISC))[(i * 2 + kv) * 64 + j];
#pragma unroll
      for (int u = 0; u < 4; ++u) { const int nl = nq * 4 + u; float s = cpe;
#pragma unroll
          for (int w = 0; w < 8; ++w) s += PART[(w * 32 + nl) * 64 + j];
          HB[nl * 64 + j] = gelu_t(s); } }
    __syncthreads();
    { const float* w2 = P.in[12] + (size_t)(i * 2 + kv) * 64 * 64 + j; float o[4] = {0.f, 0.f, 0.f, 0.f};
#pragma unroll 8
      for (int k = 0; k < 64; ++k) { const float w = w2[k * 64];
#pragma unroll
          for (int u = 0; u < 4; ++u) o[u] += HB[(nq * 4 + u) * 64 + k] * w; }
#pragma unroll
      for (int u = 0; u < 4; ++u) OB[(nq * 4 + u) * 64 + j] = o[u]; }
    __syncthreads();
#pragma unroll
    for (int u = 0; u < 4; ++u) { const int nl = nq * 4 + u, n = nt * 32 + nl;
        if (kv == 0) { u16* KC = (u16*)(P.ws + OFF_KC) + (size_t)(b * 2 + g) * 128 * 64; float val = 0.f;
            if (n < 127) { const int pos = n * 16 + 31; const float* COS = (const float*)(P.ws + OFF_ROPE); const float* SIN = COS + 2048 * 32; const int d = j & 31; const float cs = COS[pos * 32 + d], sn = SIN[pos * 32 + d];
                const float x1 = OB[nl * 64 + d], x2 = OB[nl * 64 + 32 + d]; val = (j < 32) ? (x1 * cs - x2 * sn) : (x2 * cs + x1 * sn); }
            KC[(size_t)n * 64 + j] = (u16)(cvtpk(val, 0.f) & 0xffffu);
        } else { u16* VCT = (u16*)(P.ws + OFF_VCT) + (size_t)(b * 2 + g) * 64 * 128; VCT[(size_t)j * 128 + n] = (u16)(cvtpk(n < 127 ? OB[nl * 64 + j] : 0.f, 0.f) & 0xffffu); } }
    __syncthreads();
}
DI void rope_item(const Prm& P, int item, unsigned char* ldsb) {
    const int tid = otid(), b = item >> 5, tt = item & 31, token0 = b * SEQ + tt * 64;
    u16* Z = (u16*)(P.ws + OFF_Z); const float* COS = (const float*)(P.ws + OFF_ROPE); const float* SIN = COS + 2048 * 32;
    const float SC = 0.125f * 1.4426950408889634f;
#pragma unroll 1
    for (int q = 0; q < 4; ++q) { const int e = tid + 512 * q, tok = e >> 5, hh = (e >> 2) & 7, c = e & 3, d0 = c * 8, pos = tt * 64 + tok;
        u16* p = Z + (size_t)(token0 + tok) * ZW + 1024 + hh * 64 + d0; float a[8], bq[8], o1[8], o2[8]; unpack8(*(const u32x4*)p, a); unpack8(*(const u32x4*)(p + 32), bq);
#pragma unroll
        for (int j = 0; j < 8; ++j) { const float cs = COS[pos * 32 + d0 + j], sn = SIN[pos * 32 + d0 + j]; o1[j] = (a[j] * cs - bq[j] * sn) * SC; o2[j] = (bq[j] * cs + a[j] * sn) * SC; }
        st16_pl(p, pack8(o1)); st16_pl(p + 32, pack8(o2)); }
#pragma unroll 1
    for (int q = 0; q < 2; ++q) { const int e = tid + 512 * q, tok = e >> 4, which = (e >> 2) & 3, ten = which >> 1, g = which & 1, c = e & 3, d0 = c * 8, pos = tt * 64 + tok;
        const u16* p = Z + (size_t)(token0 + tok) * ZW + (ten ? 2048 : 1792) + g * 64 + d0; float a[8], bq[8], o1[8], o2[8]; unpack8(*(const u32x4*)p, a); unpack8(*(const u32x4*)(p + 32), bq);
#pragma unroll
        for (int j = 0; j < 8; ++j) { const float cs = COS[pos * 32 + d0 + j], sn = SIN[pos * 32 + d0 + j]; o1[j] = a[j] * cs - bq[j] * sn; o2[j] = bq[j] * cs + a[j] * sn; }
        u16* dst = (u16*)(P.ws + (ten ? OFF_KWR : OFF_KSR)) + ((size_t)(b * 2 + g) * SEQ + pos) * 64 + d0; st16_pl(dst, pack8(o1)); st16_pl(dst + 32, pack8(o2)); }
    u16* TL = (u16*)ldsb;
#pragma unroll 1
    for (int q = 0; q < 4; ++q) { const int ten = q >> 1, g = q & 1, tok = tid >> 3, c = tid & 7;
        *(u32x4*)(TL + (q * 64 + tok) * 72 + c * 8) = *(const u32x4*)(Z + (size_t)(token0 + tok) * ZW + (ten ? 2176 : 1920) + g * 64 + c * 8); }
    __syncthreads();
#pragma unroll 1
    for (int q = 0; q < 4; ++q) { const int ten = q >> 1, g = q & 1, d = tid >> 3, tc = tid & 7; unsigned w[4];
#pragma unroll
        for (int j = 0; j < 4; ++j) { const unsigned lo = TL[(q * 64 + tc * 8 + 2 * j) * 72 + d], hi = TL[(q * 64 + tc * 8 + 2 * j + 1) * 72 + d]; w[j] = lo | (hi << 16); }
        u16* dst = (u16*)(P.ws + (ten ? OFF_VWT : OFF_VST)) + ((size_t)(b * 2 + g) * 64 + d) * SEQ + tt * 64 + tc * 8; st16_pl(dst, (u32x4){w[0], w[1], w[2], w[3]}); }
    __syncthreads();
}

#define MFMA32(a, b, c) __builtin_amdgcn_mfma_f32_32x32x16_bf16((a), (b), (c), 0, 0, 0)
constexpr int AT_KB = 9216, AT_VB = 8704;
constexpr int AT_OFF_V = 2 * AT_KB, AT_OFF_IMPA = AT_OFF_V + 2 * AT_VB, AT_IMP_SZ = 4 * 64 * 33 * 4, AT_OFF_IMPB = AT_OFF_IMPA + AT_IMP_SZ, AT_OFF_IMPS = AT_OFF_IMPB + AT_IMP_SZ, AT_OFF_SELM = AT_OFF_IMPS + 64 * 33 * 4;
static_assert(AT_OFF_SELM + 256 <= 131072, "attention lds");

struct AttTile { u32x4 k, v; };
DI AttTile att_gload(const u16* Kb, const u16* Vt, int vstride, int j) { const int tid = otid(), row = tid >> 3, c = tid & 7; AttTile t;
    t.k = *(const u32x4*)(Kb + ((size_t)(j * 64 + row) * 64 + c * 8)); t.v = *(const u32x4*)(Vt + ((size_t)row * vstride + j * 64 + c * 8)); return t; }
DI void att_lstore(unsigned char* lds, int buf, const AttTile& t) { const int tid = otid(), row = tid >> 3, c = tid & 7;
    *(u32x4*)(lds + buf * AT_KB + row * 144 + c * 16) = t.k;
    u32x2* vp = (u32x2*)(lds + AT_OFF_V + buf * AT_VB + row * 136 + c * 16); vp[0] = (u32x2){t.v.x, t.v.y}; vp[1] = (u32x2){t.v.z, t.v.w}; }
DI void att_qk(const unsigned char* lds, int buf, const bf16x8 (&qf)[4], int r, int h, f32x16& s0, f32x16& s1) {
    const unsigned char* kb = lds + buf * AT_KB + r * 144 + h * 16;
#pragma unroll
    for (int i = 0; i < 16; ++i) { s0[i] = 0.f; s1[i] = 0.f; }
#pragma unroll
    for (int ks = 0; ks < 4; ++ks) { const bf16x8 k0 = *(const bf16x8*)(kb + ks * 32), k1 = *(const bf16x8*)(kb + 32 * 144 + ks * 32);
        s0 = MFMA32(k0, qf[ks], s0); s1 = MFMA32(k1, qf[ks], s1); }
}
DI bf16x8 att_pack(const f32x16& p, int s) { u32x4 w; w.x = cvtpk(p[8 * s], p[8 * s + 1]); w.y = cvtpk(p[8 * s + 2], p[8 * s + 3]); w.z = cvtpk(p[8 * s + 4], p[8 * s + 5]); w.w = cvtpk(p[8 * s + 6], p[8 * s + 7]); return __builtin_bit_cast(bf16x8, w); }
template <bool GENERAL>
DI void att_step(const unsigned char* lds, int buf, const bf16x8 (&qf)[4], int r, int h, int kbase, int lo, int hi, bool lanevalid, float& m, float& l, f32x16& o0, f32x16& o1) {
    f32x16 s0, s1; att_qk(lds, buf, qf, r, h, s0, s1);
    float mx = -1e30f;
    if (GENERAL) {
#pragma unroll
        for (int i = 0; i < 16; ++i) { const int k0 = kbase + (i & 3) + 8 * (i >> 2) + 4 * h, k1 = k0 + 32; const bool v0 = (k0 >= lo) && (k0 <= hi), v1 = (k1 >= lo) && (k1 <= hi);
            s0[i] = v0 ? s0[i] : -1e30f; s1[i] = v1 ? s1[i] : -1e30f; mx = fmaxf(mx, fmaxf(s0[i], s1[i])); }
    } else {
#pragma unroll
        for (int i = 0; i < 16; ++i) mx = fmaxf(mx, fmaxf(s0[i], s1[i]));
        mx = lanevalid ? mx : -1e30f;
    }
    mx = fmaxf(mx, __shfl_xor(mx, 32));
    const float mn = fmaxf(m, mx), alpha = __builtin_amdgcn_exp2f(m - mn); m = mn;
    float ps = 0.f;
    if (GENERAL) {
#pragma unroll
        for (int i = 0; i < 16; ++i) { const float p0 = (s0[i] > -1e29f) ? __builtin_amdgcn_exp2f(s0[i] - mn) : 0.f, p1 = (s1[i] > -1e29f) ? __builtin_amdgcn_exp2f(s1[i] - mn) : 0.f; s0[i] = p0; s1[i] = p1; ps += p0 + p1; }
    } else {
        const float sub = lanevalid ? mn : __builtin_inff();
#pragma unroll
        for (int i = 0; i < 16; ++i) { const float p0 = __builtin_amdgcn_exp2f(s0[i] - sub), p1 = __builtin_amdgcn_exp2f(s1[i] - sub); s0[i] = p0; s1[i] = p1; ps += p0 + p1; }
    }
    l = l * alpha + ps;
#pragma unroll
    for (int i = 0; i < 16; ++i) { o0[i] *= alpha; o1[i] *= alpha; }
    const unsigned char* vb = lds + AT_OFF_V + buf * AT_VB + r * 136 + h * 8;
#pragma unroll
    for (int kb = 0; kb < 2; ++kb)
#pragma unroll
        for (int s = 0; s < 2; ++s) { const bf16x8 pb = att_pack(kb ? s1 : s0, s);
            const unsigned char* v0p = vb + (32 * kb + 16 * s) * 2;
            const s16x4 a0 = *(const s16x4*)v0p, a1 = *(const s16x4*)(v0p + 16), b0 = *(const s16x4*)(v0p + 32 * 136), b1 = *(const s16x4*)(v0p + 32 * 136 + 16);
            const bf16x8 pa0 = __builtin_shufflevector(a0, a1, 0, 1, 2, 3, 4, 5, 6, 7), pa1 = __builtin_shufflevector(b0, b1, 0, 1, 2, 3, 4, 5, 6, 7);
            o0 = MFMA32(pa0, pb, o0); o1 = MFMA32(pa1, pb, o1); }
}
DI void att_finish(float l, float gate, const f32x16& o0, const f32x16& o1, f32x16& out0, f32x16& out1) {
    const float lt = l + __shfl_xor(l, 32); const float f = lt > 0.f ? gate / lt : 0.f;
#pragma unroll
    for (int i = 0; i < 16; ++i) { out0[i] += f * o0[i]; out1[i] += f * o1[i]; }
}

DI void attn_item(const Prm& P, int item, unsigned char* lds) {
    const int tid = otid(), w = tid >> 6, lane = tid & 63, r = lane & 31, h = lane >> 5;
    const int qt = item >> 4, bg = item & 15, b = bg >> 1, g = bg & 1, hq = w & 3, half = w >> 2;
    const int ql = half * 32 + r, tq = qt * 64 + ql, token = b * SEQ + tq, head = g * 4 + hq;
    const u16* Z = (const u16*)(P.ws + OFF_Z); u16* CAT = (u16*)(P.ws + OFF_CAT);
    bf16x8 qf[4];
#pragma unroll
    for (int ks = 0; ks < 4; ++ks) qf[ks] = *(const bf16x8*)(Z + (size_t)token * ZW + 1024 + head * 64 + ks * 16 + h * 8);
    float gate[3];
#pragma unroll
    for (int c = 0; c < 3; ++c) gate[c] = sigm(bf2f(Z[(size_t)token * ZW + 2304 + head * 3 + c]));
    float* IMPA = (float*)(lds + AT_OFF_IMPA); float* IMPB = (float*)(lds + AT_OFF_IMPB); float* IMPS = (float*)(lds + AT_OFF_IMPS); unsigned* SELM = (unsigned*)(lds + AT_OFF_SELM);
    f32x16 out0, out1, o0, o1;
#pragma unroll
    for (int i = 0; i < 16; ++i) { out0[i] = 0.f; out1[i] = 0.f; o0[i] = 0.f; o1[i] = 0.f; }
    const size_t bgo = (size_t)(b * 2 + g);
    unsigned myselm = 0u, um = 0u;
    const int hic = (tq - 31) >> 4;
#pragma unroll 1
    for (int br = 0; br <= 2; ++br) {
        const u16* Kb; const u16* Vt; int vstride; unsigned tm; int wlo = 0;
        const unsigned causal = (qt >= 31) ? 0xffffffffu : ((2u << qt) - 1u);
        if (br == 0) { Kb = (const u16*)(P.ws + OFF_KC) + bgo * 128 * 64; Vt = (const u16*)(P.ws + OFF_VCT) + bgo * 64 * 128; vstride = 128; tm = 3u; }
        else if (br == 1) { Kb = (const u16*)(P.ws + OFF_KSR) + bgo * SEQ * 64; Vt = (const u16*)(P.ws + OFF_VST) + bgo * 64 * SEQ; vstride = SEQ; tm = um & causal; }
        else { Kb = (const u16*)(P.ws + OFF_KWR) + bgo * SEQ * 64; Vt = (const u16*)(P.ws + OFF_VWT) + bgo * 64 * SEQ; vstride = SEQ; const int jlo = (qt * 64 - 511) > 0 ? ((qt * 64 - 511) >> 6) : 0; tm = causal & ~((1u << jlo) - 1u); wlo = tq - 511; }
#pragma unroll
        for (int i = 0; i < 16; ++i) { o0[i] = 0.f; o1[i] = 0.f; }
        float m = -1e30f, l = 0.f;
        int j = __ffs(tm) - 1; int buf = 0;
        { AttTile t = att_gload(Kb, Vt, vstride, j); att_lstore(lds, 0, t); }
        __syncthreads();
#pragma unroll 1
        while (true) {
            tm &= tm - 1u; const int nj = tm ? (__ffs(tm) - 1) : -1;
            AttTile nt; if (nj >= 0) nt = att_gload(Kb, Vt, vstride, nj);
            const int hi = (br == 0) ? hic : ((br == 1) ? (((myselm >> j) & 1u) ? tq : -1) : tq);
            { const int kb0 = j * 64; const bool full_l = (wlo <= kb0) && (kb0 + 63 <= hi), empty_l = (hi < kb0) || (wlo > kb0 + 63);
              if (__builtin_amdgcn_ballot_w64(!full_l && !empty_l) != 0ull) att_step<true>(lds, buf, qf, r, h, kb0, wlo, hi, full_l, m, l, o0, o1);
              else att_step<false>(lds, buf, qf, r, h, kb0, wlo, hi, full_l, m, l, o0, o1); }
            if (nj >= 0) att_lstore(lds, buf ^ 1, nt);
            __syncthreads();
            if (nj < 0) break;
            j = nj; buf ^= 1;
        }
        att_finish(l, br == 0 ? gate[0] : (br == 1 ? gate[1] : gate[2]), o0, o1, out0, out1);
        if (br == 0) {
            const float lt = l + __shfl_xor(l, 32); const float inv = lt > 0.f ? 1.f / lt : 0.f;
#pragma unroll 1
            for (int jt = 0; jt < 2; ++jt) { f32x16 s0, s1; att_qk(lds, jt, qf, r, h, s0, s1);
#pragma unroll
                for (int kb = 0; kb < 2; ++kb)
#pragma unroll
                    for (int gi = 0; gi < 4; ++gi) { float p[4];
#pragma unroll
                        for (int e = 0; e < 4; ++e) { const int i = gi * 4 + e; const int n = jt * 64 + 32 * kb + 8 * gi + 4 * h + e; const float sv = kb ? s1[i] : s0[i]; p[e] = (n <= hic) ? __builtin_amdgcn_exp2f(sv - m) * inv : 0.f; }
                        const int jp = jt * 16 + 8 * kb + 2 * gi + h;
                        IMPA[(hq * 64 + ql) * 33 + jp] = (p[0] + p[1]) + (p[2] + p[3]);
                        if (jp + 1 < 32) IMPB[(hq * 64 + ql) * 33 + jp + 1] = p[3]; } }
            __syncthreads();
            for (int e = tid; e < 64 * 32; e += 512) { const int q = e >> 5, jj = e & 31; float sacc = 0.f;
#pragma unroll
                for (int hh = 0; hh < 4; ++hh) { sacc += IMPA[(hh * 64 + q) * 33 + jj]; if (jj > 0) sacc += IMPB[(hh * 64 + q) * 33 + jj]; }
                IMPS[q * 33 + jj] = sacc; }
            __syncthreads();
            {
              const int cur = qt, qq = tid >> 3, sub = tid & 7; unsigned mask;
              if (cur <= 7) mask = (2u << cur) - 1u;
              else { mask = 1u | (1u << cur) | (1u << (cur - 1));
                  float v[4];
#pragma unroll
                  for (int e = 0; e < 4; ++e) { const int jj = sub * 4 + e; v[e] = (jj >= 1 && jj <= cur - 2) ? IMPS[qq * 33 + jj] : -1.f; }
#pragma unroll 1
                  for (int rnd = 0; rnd < 5; ++rnd) { float bv = v[0]; int bj = sub * 4;
#pragma unroll
                      for (int e = 1; e < 4; ++e) if (v[e] > bv) { bv = v[e]; bj = sub * 4 + e; }
#pragma unroll
                      for (int o = 1; o <= 4; o <<= 1) { const float ov = __shfl_xor(bv, o); const int oj = __shfl_xor(bj, o); if (ov > bv || (ov == bv && oj < bj)) { bv = ov; bj = oj; } }
                      if (bv >= 0.f) mask |= 1u << bj;
#pragma unroll
                      for (int e = 0; e < 4; ++e) v[e] = (bj == sub * 4 + e) ? -1.f : v[e]; } }
              if (sub == 0) SELM[qq] = mask; }
            __syncthreads();
            myselm = SELM[ql]; um = SELM[lane];
#pragma unroll
            for (int o = 32; o >= 1; o >>= 1) um |= __shfl_xor(um, o);
        }
    }
    u16* op = CAT + (size_t)token * 1024 + 512 + head * 64 + 4 * h;
#pragma unroll
    for (int gi = 0; gi < 4; ++gi) { u32x2 a, c; a.x = cvtpk(out0[gi * 4], out0[gi * 4 + 1]); a.y = cvtpk(out0[gi * 4 + 2], out0[gi * 4 + 3]); c.x = cvtpk(out1[gi * 4], out1[gi * 4 + 1]); c.y = cvtpk(out1[gi * 4 + 2], out1[gi * 4 + 3]);
        st8_pl(op + 8 * gi, a); st8_pl(op + 32 + 8 * gi, c); }
    __syncthreads();
}

DI void s5_scan_task(const Prm& P, int i, int L) {
    const int tid = otid();
    if (tid < 128) { const int g = L >> 2, pml = L & 3, p = tid & 63, b = 2 * pml + (tid >> 6);
        const float* E = (const float*)(P.ws + OFF_E) + (size_t)(g * 1024 + b * 128) * 128; u16* XP = (u16*)(P.ws + OFF_UD) + (size_t)(g * 1024 + b * 128) * 256;
        const float* LAML = (const float*)(P.ws + OFF_MISC) + 4096 + (size_t)(i * 32 + g) * 128; const float lr = LAML[p * 2], li = LAML[p * 2 + 1];
        float xr = 0.f, xi = 0.f;
#pragma unroll 1
        for (int c0 = 0; c0 < 128; c0 += 16) { float er[16], ei[16];
#pragma unroll
            for (int q = 0; q < 16; ++q) { er[q] = E[(size_t)(c0 + q) * 128 + p]; ei[q] = E[(size_t)(c0 + q) * 128 + 64 + p]; }
#pragma unroll
            for (int q = 0; q < 16; ++q) { u16* xp = XP + (size_t)(c0 + q) * 256; xp[p] = (u16)(cvtpk(xr, 0.f) & 0xffffu); xp[64 + p] = (u16)(cvtpk(xi, 0.f) & 0xffffu); xp[128 + p] = 0; xp[192 + p] = 0;
                const float nr = lr * xr - li * xi + er[q], ni = lr * xi + li * xr + ei[q]; xr = nr; xi = ni; } }
    }
}
template <int WLEN> DI void pool_one(const u16* ZC, u16* CAT, int tok, int cc) {
    const int pos = tok & (SEQ - 1); const int cnt = (pos + 1) < WLEN ? (pos + 1) : WLEN;
    u32x4 raw[WLEN];
#pragma unroll
    for (int q = 0; q < WLEN; ++q) { raw[q] = (u32x4){0u, 0u, 0u, 0u}; if (q <= pos) raw[q] = *(const u32x4*)(ZC + (size_t)(tok - q) * 512 + cc * 8); }
    float s[8], z0[8];
    unpack8(raw[0], z0);
#pragma unroll
    for (int j = 0; j < 8; ++j) s[j] = z0[j];
#pragma unroll
    for (int q = 1; q < WLEN; ++q) { float z[8]; unpack8(raw[q], z);
#pragma unroll
        for (int j = 0; j < 8; ++j) s[j] += z[j]; }
    const float ic = __builtin_amdgcn_rcpf((float)cnt);
#pragma unroll
    for (int j = 0; j < 8; ++j) s[j] = s[j] * ic - z0[j];
    st16_pl(CAT + (size_t)tok * 1024 + cc * 8, pack8(s));
}
DI void pool_tasks(const Prm& P, int first) {
    const int tid = otid(); const u16* ZC = (const u16*)(P.ws + OFF_ZC); u16* CAT = (u16*)(P.ws + OFF_CAT); const int nb = ogdim() - first;
    for (int idx = (obid() - first) * 512 + tid; idx < T * 64; idx += nb * 512) { const int grp = (idx >> 6) & 3, tok = ((idx >> 8) << 2) | ((idx >> 4) & 3), cc = grp * 16 + (idx & 15);
        if (grp == 0) pool_one<2>(ZC, CAT, tok, cc); else if (grp == 1) pool_one<4>(ZC, CAT, tok, cc); else if (grp == 2) pool_one<8>(ZC, CAT, tok, cc); else pool_one<16>(ZC, CAT, tok, cc); }
}
DI void phase_final(const Prm& P) {
    const int tid = otid(), lane = tid & 63, wave = tid >> 6; float* X = P.out; const float* SS = (const float*)(P.ws + OFF_SS); const float* gw = P.in[5];
    const u16* XB = (const u16*)(P.ws + OFF_XB);
    for (int row = obid() * 8 + wave; row < T; row += ogdim() * 8) { const float rs = row_rstd(SS, row);
#pragma unroll
        for (int i = 0; i < 2; ++i) { const int col = lane * 8 + 512 * i; const size_t off = (size_t)row * 1024 + col; float hi[8];
            unpack8(*(const u32x4*)(XB + off), hi);
            const f32x4 g0 = *(const f32x4*)(gw + col), g1 = *(const f32x4*)(gw + col + 4);
            f32x4 a, b2;
            a.x = hi[0] * rs * g0.x; a.y = hi[1] * rs * g0.y; a.z = hi[2] * rs * g0.z; a.w = hi[3] * rs * g0.w;
            b2.x = hi[4] * rs * g1.x; b2.y = hi[5] * rs * g1.y; b2.z = hi[6] * rs * g1.z; b2.w = hi[7] * rs * g1.w;
            *(f32x4*)(X + off) = a; *(f32x4*)(X + off + 4) = b2; } }
}

#ifndef REP_MASK
#define REP_MASK 0
#endif
#ifndef REP_TY
#define REP_TY -1
#define REP_N 0
#endif
enum { PH_GU = 0, PH_DOWN, PH_EVIN, PH_E2, PH_ATTN, PH_EVOUT, PH_ODIN, PH_S5A, PH_SCAN, PH_S5B, PH_GLU, PH_ODOUT };
DI int slot_type(int odd, int s) {
    if (!odd) { switch (s) { case 0: return PH_GU; case 1: return PH_DOWN; case 2: return PH_EVIN; case 3: return PH_E2; case 4: return PH_ATTN; case 5: return PH_EVOUT; case 6: return PH_GU; default: return PH_DOWN; } }
    switch (s) { case 0: return PH_GU; case 1: return PH_DOWN; case 2: return PH_ODIN; case 3: return PH_S5A; case 4: return PH_GLU; case 5: return PH_ODOUT; case 6: return PH_GU; default: return PH_DOWN; }
}

typedef const __attribute__((address_space(4))) Prm* KPrm;
DI int opq(int v) { asm volatile("" : "+s"(v)); return v; }
#define XB_TMO      128
#define XB_XCNT(j)  (256  + 64 * (j))
#define XB_XSUB(j)  (1280 + 64 * (j))
#define XB_XGEN(j)  (2304 + 64 * (j))
#define XB_TOP      3328
#define XB_TOPGEN   3392
#define XB_SPIN_CAP (1u << 20)
DI unsigned xb_ld(unsigned* p) { return __hip_atomic_load(p, __ATOMIC_RELAXED, __HIP_MEMORY_SCOPE_AGENT); }
DI unsigned xb_add(unsigned* p, unsigned v) { return __hip_atomic_fetch_add(p, v, __ATOMIC_RELAXED, __HIP_MEMORY_SCOPE_AGENT); }
DI unsigned xb_xcc_id() { return (unsigned)__builtin_amdgcn_s_getreg((3 << 11) | 20) & 0xFu; }
#define XB_SPIN(cond, bar) do { unsigned _sp = 0; while (cond) { __builtin_amdgcn_s_sleep(1); \
    if ((++_sp & 255u) == 0u) { if (xb_ld(&(bar)[XB_TMO])) break; if (_sp > XB_SPIN_CAP) { atomicAdd(&(bar)[XB_TMO], 1u); break; } } } } while (0)
DI void xcd_barrier_complete(unsigned* bar, unsigned x, unsigned& nloc, unsigned& nx) {
    const unsigned G = (unsigned)ogdim();
    unsigned sum, cnt, mine, sp = 0u;
    for (;;) {
        sum = 0u; cnt = 0u; mine = 0u;
#pragma unroll
        for (unsigned j = 0; j < 16; ++j) { const unsigned c = xb_ld(&bar[XB_XCNT(j)]); sum += c; cnt += (c > 0u) ? 1u : 0u; mine = (j == x) ? c : mine; }
        if (sum == G) break;
        __builtin_amdgcn_s_sleep(1);
        if ((++sp & 255u) == 0u) { if (xb_ld(&bar[XB_TMO])) break; if (sp > XB_SPIN_CAP) { atomicAdd(&bar[XB_TMO], 1u); break; } }
    }
    nloc = mine > 0u ? mine : 1u; nx = cnt > 0u ? cnt : 1u;
}
DI void grid_barrier(unsigned* bar, volatile PG8_LAS unsigned* st) {
    asm volatile("s_waitcnt vmcnt(0)" ::: "memory");
    __syncthreads();
    if (otid() == 0) {
        const unsigned x = xb_xcc_id();
        __builtin_amdgcn_s_waitcnt(0);
        unsigned nloc = st[0], nx = st[1];
        if (nloc == 0u) { xcd_barrier_complete(bar, x, nloc, nx); st[0] = nloc; st[1] = nx; }
        const unsigned old = xb_add(&bar[XB_XSUB(x)], 1u);
        const unsigned gen = old / nloc;
        if (old + 1u == (gen + 1u) * nloc) {
            __builtin_amdgcn_fence(__ATOMIC_RELEASE, "agent");
            asm volatile("s_waitcnt vmcnt(0)" ::: "memory");
            const unsigned og = xb_add(&bar[XB_TOP], 1u);
            const unsigned tg = og / nx;
            if (og + 1u == (tg + 1u) * nx) xb_add(&bar[XB_TOPGEN], 1u);
            else XB_SPIN(xb_ld(&bar[XB_TOPGEN]) == tg, bar);
            __builtin_amdgcn_fence(__ATOMIC_ACQUIRE, "agent");
            xb_add(&bar[XB_XGEN(x)], 1u);
            asm volatile("s_waitcnt vmcnt(0)" ::: "memory");
        } else {
            XB_SPIN(xb_ld(&bar[XB_XGEN(x)]) == gen, bar);
            __builtin_amdgcn_fence(__ATOMIC_ACQUIRE, "agent");
            asm volatile("s_waitcnt vmcnt(0)" ::: "memory");
        }
    }
    __syncthreads();
}
DI Prm load_prm(KPrm kp) { Prm P;
#pragma unroll
    for (int i = 0; i < 26; ++i) P.in[i] = kp->in[i];
    P.out = kp->out; P.ws = kp->ws; return P; }
#ifndef GSP2
#define GSP2 true
#endif
__global__ void __launch_bounds__(512, 2) mega_fwd(Prm P_unused, int ph_lo, int ph_hi) {
    extern __shared__ __attribute__((aligned(16))) unsigned char lds[];
    cg::grid_group grid = cg::this_grid();
    PG8_LAS unsigned char* glds = (PG8_LAS unsigned char*)lds;
    int ph = 0;
    { volatile PG8_LAS unsigned* st = (volatile PG8_LAS unsigned*)(glds + 147392); if (otid() < 2) st[otid()] = 0u; __syncthreads();
      KPrm kp0 = (KPrm)__builtin_amdgcn_kernarg_segment_ptr(); unsigned* bar0 = (unsigned*)(kp0->ws + OFF_BAR); if (otid() == 0) (void)xb_add(&bar0[XB_XCNT(xb_xcc_id())], 1u); }
    if (ph_lo < 0) grid.sync();
#define PHASE_BEGIN if (ph >= ph_lo && ph < ph_hi) { KPrm kp = (KPrm)__builtin_amdgcn_kernarg_segment_ptr(); asm volatile("" : "+s"(kp)); const Prm P = load_prm(kp); unsigned char* ws = P.ws; \
    u16* XB = (u16*)(ws + OFF_XB); float* SS = (float*)(ws + OFF_SS); u16* CAT = (u16*)(ws + OFF_CAT); (void)XB; (void)SS; (void)CAT; const int G = ogdim(), c = obid(); (void)G; (void)c;
#define PHASE_END if (ph + 1 < ph_hi) { grid_barrier((unsigned*)(ws + OFF_BAR), (volatile PG8_LAS unsigned*)(glds + 147392)); } } ++ph;
#ifndef SKIP_PREP
#pragma unroll 1
    for (int pass = 0; pass <= ((REP_TY == 98) ? REP_N : 0); ++pass) {
    PHASE_BEGIN for (int rep = 0; rep <= ((REP_TY == 99) ? REP_N : 0); ++rep) phase_prep(P, lds); PHASE_END
#else
    ++ph;
#endif
#pragma unroll 1
    for (int l = 0; l < 4; ++l) { const int odd = l & 1, i = l >> 1, ns = 8;
#pragma unroll 1
        for (int s = 0; s < ns; ++s) {
            PHASE_BEGIN
            const int ty = slot_type(odd, s); const int fj = (s < 2) ? 0 : 1; const int lj = l * 2 + fj;
            const int nrep = (ty == REP_TY || ((REP_MASK >> ty) & 1)) ? REP_N : 0;
#pragma unroll 1
            for (int rep = 0; rep <= nrep; ++rep) {
#ifdef REP_BAR
            if (rep > 0) grid_barrier((unsigned*)(ws + OFF_BAR), (volatile PG8_LAS unsigned*)(glds + 147392));
#endif
#ifndef SKIP_GU
            if (ty == PH_GU) {
                pg8::Gemm gm{XB, (const u16*)(ws + OFF_WFFN + (size_t)lj * SZ_WFFN), T, 5632, opq(1024)}; pg8::StaticOrder S; S.init(T, 5632, G, c);
                EpiGated<0> E{(u16*)(ws + OFF_ACT), FF, 0, SS};
                pg8::gemm_phase<EpiGated<0>, pg8::StaticOrder, true, true>(glds, gm, S, E);
                if (false && c >= 128 && l < 3 && rep == 0) { KPrm kp2 = (KPrm)__builtin_amdgcn_kernarg_segment_ptr(); asm volatile("" : "+s"(kp2)); const Prm P2 = load_prm(kp2); convert_layer_part(P2, l + 1, fj, c - 128, G - 128, (float*)lds); }
            } else
#endif
#ifndef SKIP_GLU
            if (ty == PH_GLU) {
                pg8::Gemm gm{(const u16*)(ws + OFF_YG), (const u16*)(ws + OFF_WGLU) + (size_t)i * 1024 * 512, T, 1024, opq(512)}; pg8::StaticOrder S; S.init(T, 1024, G, c);
                EpiGated<1> E{CAT, 1024, 512, nullptr};
                pg8::gemm_phase<EpiGated<1>, pg8::StaticOrder, true, true>(glds, gm, S, E);
            } else
#endif
#ifndef SKIP_RES
            if (ty == PH_DOWN || ty == PH_EVOUT || ty == PH_ODOUT) {
                const u16* A = (ty == PH_DOWN) ? (const u16*)(ws + OFF_ACT) : CAT;
                const u16* Bt = (ty == PH_DOWN) ? (const u16*)(ws + OFF_WFFN + (size_t)lj * SZ_WFFN + SZ_WGU) : (ty == PH_EVOUT ? (const u16*)(ws + OFF_WEVOUT) + (size_t)i * 1024 * 1024 : (const u16*)(ws + OFF_WODOUT) + (size_t)i * 1024 * 1024);
                pg8::Gemm gm{A, Bt, T, 1024, opq((ty == PH_DOWN) ? FF : 1024)}; pg8::StaticOrder S; S.init(T, 1024, G, c);
                EpiResid E{XB, SS, (rep < nrep) ? 0.f : ((ty == PH_DOWN) ? 0.5f : 1.0f)};
                pg8::gemm_phase<EpiResid, pg8::StaticOrder, true, GSP2>(glds, gm, S, E);
            } else
#endif
#ifndef SKIP_EVIN
            if (ty == PH_EVIN) {
                pg8::Gemm gm{XB, (const u16*)(ws + OFF_WEVIN) + (size_t)i * ZW * 1024, T, ZW, opq(1024)}; pg8::StaticOrder S; S.init(T, ZW, G, c);
                EpiEvIn E{(u16*)(ws + OFF_Z), SS};
                pg8::gemm_phase<EpiEvIn, pg8::StaticOrder, true, GSP2>(glds, gm, S, E);
            } else
#endif
#ifndef SKIP_ODIN
            if (ty == PH_ODIN) {
                pg8::Gemm gm{XB, (const u16*)(ws + OFF_WODIN) + (size_t)i * 1024 * 1024, T, 1024, opq(1024)}; pg8::StaticOrder S; S.init(T, 1024, G, c);
                EpiOdIn E{(u16*)(ws + OFF_ZC), (u16*)(ws + OFF_UD), SS};
                pg8::gemm_phase<EpiOdIn, pg8::StaticOrder, true, GSP2>(glds, gm, S, E);
            } else
#endif
#ifndef SKIP_S5A
            if (ty == PH_S5A) {
                if (c < 128) {
                    { pg8::Gemm gm{(const u16*)(ws + OFF_UD), (const u16*)(ws + OFF_BT1) + (size_t)i * 32 * 512 * 256, 32 * 1024, 32 * 512, opq(256)}; S5FA S{c};
                      EpiS5A E{(float*)(ws + OFF_YIN), (float*)(ws + OFF_E)};
                      pg8::gemm_phase<EpiS5A, S5FA, true, false>(glds, gm, S, E); }
                    asm volatile("s_waitcnt vmcnt(0)" ::: "memory"); __threadfence_block(); __syncthreads();
                    s5_scan_task(P, i, c);
                    asm volatile("s_waitcnt vmcnt(0)" ::: "memory"); __threadfence_block(); __syncthreads();
                    { pg8::Gemm gm{(const u16*)(ws + OFF_UD), (const u16*)(ws + OFF_FMAT) + (size_t)i * 32 * 256 * 256, 32 * 1024, 32 * 256, opq(256)}; S5FB S{c};
                      EpiS5B E{(const float*)(ws + OFF_YIN), (u16*)(ws + OFF_YG)};
                      pg8::gemm_phase<EpiS5B, S5FB, true, false>(glds, gm, S, E); }
                } else pool_tasks(P, 128);
            } else
#endif
#ifndef SKIP_E2
            if (ty == PH_E2) {
                for (int it = c; it < 1408; it += G) { if (it < 128) cmp_item(P, i, it, (float*)lds); else if (it < 384) { if (!rep) rope_item(P, it - 128, lds); } else gmlp_item(P, i, it - 384, lds); }
            } else
#endif
#ifndef SKIP_ATTN
            if (ty == PH_ATTN) {
                for (int it = c; it < 256; it += G) {
#pragma unroll 1
                    for (int k2 = 0; k2 < 2; ++k2) attn_item(P, k2 ? 511 - it : it, lds); }
            }
#endif
            {}
            }
            if (REP_TY == 100) { for (int q = 0; q < REP_N; ++q) { grid_barrier((unsigned*)(ws + OFF_BAR), (volatile PG8_LAS unsigned*)(glds + 147392)); } }
            PHASE_END
        }
    }
    }
    PHASE_BEGIN phase_final(P); PHASE_END
}
constexpr int N_PHASES = 1 + 8 + 8 + 8 + 8 + 1;

extern "C" void kernel_launch(void* const* d_in, const int* in_sizes, int n_in, void* d_out, int out_size, void* d_ws, size_t ws_size, hipStream_t stream) {
    static int grid = 0;
    if (grid == 0) {
        if (n_in != 26 || out_size != T * DM || ws_size < WS_NEED) { fprintf(stderr, "kernel_launch: unexpected problem (n_in %d out %d ws %zu need %zu)\n", n_in, out_size, ws_size, (size_t)WS_NEED); grid = -1; return; }
        int dev = 0, cus = 0, per_cu = 0;
        hipGetDevice(&dev); hipDeviceGetAttribute(&cus, hipDeviceAttributeMultiprocessorCount, dev);
        if (hipFuncSetAttribute((const void*)mega_fwd, hipFuncAttributeMaxDynamicSharedMemorySize, LDS_BYTES) != hipSuccess) { fprintf(stderr, "kernel_launch: hipFuncSetAttribute failed\n"); grid = -1; return; }
        hipOccupancyMaxActiveBlocksPerMultiprocessor(&per_cu, (const void*)mega_fwd, 512, LDS_BYTES);
        (void)hipGetLastError();
        if (per_cu < 1) fprintf(stderr, "kernel_launch: occupancy query says %d blocks per CU\n", per_cu);
        grid = cus > 0 ? cus : 256;
    }
    if (grid < 0) return;
    if (hipMemsetAsync((char*)d_ws + OFF_BAR, 0, 16384, stream) != hipSuccess) { fprintf(stderr, "kernel_launch: memset failed\n"); return; }
    Prm p{};
    for (int i = 0; i < 26; ++i) p.in[i] = (const float*)d_in[i];
    p.out = (float*)d_out; p.ws = (unsigned char*)d_ws;
#ifndef MULTI_LAUNCH
    int lo = 0, hi = (REP_TY == 98) ? 100000 : N_PHASES;
    void* args[] = {&p, &lo, &hi};
    hipError_t e = hipLaunchCooperativeKernel((const void*)mega_fwd, dim3(grid), dim3(512), args, LDS_BYTES, stream);
    if (e != hipSuccess) fprintf(stderr, "cooperative launch failed: %s (grid %d)\n", hipGetErrorString(e), grid);
#else
    for (int ph = 0; ph < N_PHASES; ++ph) hipLaunchKernelGGL(mega_fwd, dim3(grid), dim3(512), LDS_BYTES, stream, p, ph, ph + 1);
#endif
}
```

```cpp
#include <hip/hip_runtime.h>
#include <hip/hip_cooperative_groups.h>
#include <cstdio>
namespace cg = cooperative_groups;
__device__ __forceinline__ int otid() { int t = threadIdx.x; asm volatile("" : "+v"(t)); return t; }
__device__ __forceinline__ int obid() { int t = blockIdx.x; asm volatile("" : "+s"(t)); return t; }
__device__ __forceinline__ int ogdim() { int t = gridDim.x; asm volatile("" : "+s"(t)); return t; }
namespace pg8 {
#define PG8_LAS __attribute__((address_space(3)))
typedef unsigned short bf16_t;
typedef short bf16x8 __attribute__((ext_vector_type(8)));
typedef float f32x4 __attribute__((ext_vector_type(4)));
typedef unsigned u32x4 __attribute__((ext_vector_type(4)));
constexpr int BM = 256, BK = 64, HALF = 128, HTB = HALF * BK * 2  , STAGE_BYTES = 8 * HTB, NXCD = 8, WGM = 8;

__host__ __device__ __forceinline__ int lds_byte(int r, int c) { const int st = (r >> 4) * 2 + (c >> 5), rr = r & 15, cc = c & 31, ob = rr * 64 + cc * 2; return st * 1024 + (ob ^ (((ob >> 9) & 1) << 5)); }
__host__ __device__ __forceinline__ void stage_rc(int b, int& R, int& C) { const int st = b / 1024, sb = b % 1024, swz = sb ^ (((sb >> 9) & 1) << 5); R = (st >> 1) * 16 + swz / 64; C = (st & 1) * 32 + (swz % 64) / 2; }
__host__ __device__ __forceinline__ int perm32(int rho) { const int n = rho >> 4, i = rho & 15; return 8 * (i >> 2) + 4 * n + (i & 3); }

struct Unit { int pm, pn; };
struct Gemm { const bf16_t* A; const bf16_t* Bt; int M, N, K; };

struct StaticOrder {
    int nM, nN, nwg, G, c;
    __host__ __device__ void init(int M, int N, int G_, int c_) { nM = M / BM; nN = N / BM; nwg = nM * nN; G = G_; c = c_; }
    __host__ __device__ bool next(int i, Unit& u) const {
        const long L = (long)i * G + c; if (L >= nwg) return false;
        int wgid = (int)L; { const int q = nwg / NXCD, r = nwg % NXCD, xcd = wgid % NXCD, off = wgid / NXCD; wgid = (xcd < r ? xcd * (q + 1) : r * (q + 1) + (xcd - r) * q) + off; }
        const int nig = WGM * nN, gid = wgid / nig, fm = gid * WGM, gsz = (nM - fm) < WGM ? (nM - fm) : WGM;
        u.pm = fm + ((wgid % nig) % gsz); u.pn = (wgid % nig) / gsz; return true;
    }
    __device__ __forceinline__ void a_ready(const Unit&) const {}
    __device__ __forceinline__ void done(const Unit&) const {}
};
__device__ __forceinline__ unsigned cvt_pk_bf16(float lo, float hi) { unsigned r; asm volatile("v_cvt_pk_bf16_f32 %0, %1, %2" : "=v"(r) : "v"(lo), "v"(hi)); return r; }

template <class Epi, class Sched, bool ALIGN_EPI = false, bool SP2 = false>
__device__ __forceinline__ void gemm_phase(PG8_LAS unsigned char* lds, const Gemm g, const Sched& S, const Epi& E) {
    const int tid = otid(), wid = __builtin_amdgcn_readfirstlane(tid >> 6), lane = tid & 63, wr = wid >> 2, wc = wid & 3, fr = lane & 15, fq = lane >> 4;
    const int K = g.K, nt = K / BK;
    unsigned voffA[2], voffB[2];
#pragma unroll
    for (int i = 0; i < 2; ++i) { int R, C; stage_rc(tid * 16 + i * 8192, R, C); const int Rb = Epi::PERM ? ((R & ~31) + perm32(R & 31)) : R;
        voffA[i] = (unsigned)(R * K + C) * 2u; voffB[i] = (unsigned)(Rb * K + C) * 2u; }
    const size_t kstep = (size_t)(BK * 2);
    const size_t hstep = (size_t)HALF * K * 2;
    const size_t tstep = 2 * hstep;
    const unsigned ldsw = (unsigned)wid * 1024u;
    const int aoff = lds_byte(wr * 64 + fr, fq * 8), boff = lds_byte(wc * 32 + fr, fq * 8);
#define PG8_SA(b, h) (((b) * 2 + (h)) * HTB)
#define PG8_SB(b, h) ((4 + (b) * 2 + (h)) * HTB)
#define PG8_STAGE(bufoff, gbase, voff) do { _Pragma("unroll") for (int _i = 0; _i < 2; ++_i) \
        __builtin_amdgcn_global_load_lds((const unsigned*)((const char*)(gbase) + (voff)[_i]), (PG8_LAS unsigned*)(lds + (bufoff) + ldsw + _i * 8192), 16, 0, 0); } while (0)
#define PG8_LDA(dst, b, h) do { _Pragma("unroll") for (int m = 0; m < 4; ++m) _Pragma("unroll") for (int k = 0; k < 2; ++k) dst[m][k] = *(const PG8_LAS bf16x8*)(lds + PG8_SA(b, h) + aoff + m * 2048 + k * 1024); } while (0)
#define PG8_LDB(dst, b, h) do { _Pragma("unroll") for (int n = 0; n < 2; ++n) _Pragma("unroll") for (int k = 0; k < 2; ++k) dst[n][k] = *(const PG8_LAS bf16x8*)(lds + PG8_SB(b, h) + boff + n * 2048 + k * 1024); } while (0)
#define PG8_MMA(ai, bj, At, Bt) do { __builtin_amdgcn_s_setprio(1); _Pragma("unroll") for (int m = 0; m < 4; ++m) _Pragma("unroll") for (int n = 0; n < 2; ++n) _Pragma("unroll") for (int k = 0; k < 2; ++k) \
        acc[ai][bj][m][n] = __builtin_amdgcn_mfma_f32_16x16x32_bf16(Bt[n][k], At[m][k], acc[ai][bj][m][n], 0, 0, 0); __builtin_amdgcn_s_setprio(0); } while (0)
#define PG8_WAIT_V(n) asm volatile("s_waitcnt vmcnt(" #n ")" ::: "memory")
#define PG8_WAIT_L(n) asm volatile("s_waitcnt lgkmcnt(" #n ")" ::: "memory")
#define PG8_BAR __builtin_amdgcn_s_barrier()
#define PG8_SCHED __builtin_amdgcn_sched_barrier(0)
    Unit cur, nxt; int ui = 0;
    if (!S.next(0, cur)) return;
    f32x4 acc[2][2][4][2];
#pragma unroll
    for (int a = 0; a < 2; ++a)
#pragma unroll
        for (int b = 0; b < 2; ++b)
#pragma unroll
            for (int m = 0; m < 4; ++m)
#pragma unroll
                for (int n = 0; n < 2; ++n) acc[a][b][m][n] = (f32x4){0.f, 0.f, 0.f, 0.f};
    bf16x8 At[4][2], B0[2][2], B1[2][2];
    const char* cA = (const char*)g.A + (size_t)cur.pm * tstep; const char* cB = (const char*)g.Bt + (size_t)cur.pn * tstep;
    S.a_ready(cur);
    if constexpr (SP2) {
        PG8_STAGE(PG8_SB(0, 0), cB, voffB); PG8_STAGE(PG8_SB(0, 1), cB + hstep, voffB); PG8_STAGE(PG8_SA(0, 0), cA, voffA); PG8_STAGE(PG8_SA(0, 1), cA + hstep, voffA);
        if (wr == 1) PG8_BAR;
        PG8_WAIT_V(2); PG8_BAR;
        PG8_STAGE(PG8_SB(1, 0), cB + kstep, voffB); PG8_STAGE(PG8_SA(1, 0), cA + kstep, voffA); PG8_STAGE(PG8_SB(1, 1), cB + hstep + kstep, voffB);
        PG8_WAIT_V(6); PG8_BAR;
    } else {
        PG8_STAGE(PG8_SB(0, 0), cB, voffB); PG8_STAGE(PG8_SA(0, 0), cA, voffA); PG8_STAGE(PG8_SB(0, 1), cB + hstep, voffB); PG8_STAGE(PG8_SA(0, 1), cA + hstep, voffA);
        if (wr == 1) PG8_BAR;
        PG8_WAIT_V(4); PG8_BAR;
        PG8_STAGE(PG8_SB(1, 0), cB + kstep, voffB); PG8_STAGE(PG8_SA(1, 0), cA + kstep, voffA); PG8_STAGE(PG8_SB(1, 1), cB + hstep + kstep, voffB);
        PG8_WAIT_V(6); PG8_BAR;
    }
    for (;;) {
        const bool has_next = S.next(ui + 1, nxt);
        const char* nA = has_next ? (const char*)g.A + (size_t)nxt.pm * tstep : cA; const char* nB = has_next ? (const char*)g.Bt + (size_t)nxt.pn * tstep : cB;
        for (int t = 0; t < nt; t += 2) {
            const bool last = (t == nt - 2);
            const char* a1 = cA + (size_t)(t + 1) * kstep;
            const char* a2 = last ? nA : cA + (size_t)(t + 2) * kstep; const char* b2 = last ? nB : cB + (size_t)(t + 2) * kstep;
            const char* a3 = a2 + kstep; const char* b3 = b2 + kstep;
            if (last && has_next) S.a_ready(nxt);
            if constexpr (SP2) {
            PG8_LDB(B0, 0, 0); PG8_LDB(B1, 0, 1); PG8_SCHED; PG8_LDA(At, 0, 0); PG8_STAGE(PG8_SA(1, 1), a1 + hstep, voffA);
            PG8_WAIT_V(8); PG8_WAIT_L(0); PG8_BAR; PG8_MMA(0, 0, At, B0); PG8_MMA(0, 1, At, B1); PG8_BAR; PG8_SCHED;
            PG8_LDA(At, 0, 1); PG8_STAGE(PG8_SB(0, 0), b2, voffB); PG8_STAGE(PG8_SB(0, 1), b2 + hstep, voffB); PG8_STAGE(PG8_SA(0, 0), a2, voffA);
            PG8_WAIT_V(8); PG8_WAIT_L(0); PG8_BAR; PG8_MMA(1, 0, At, B0); PG8_MMA(1, 1, At, B1); PG8_BAR; PG8_SCHED;
            PG8_LDB(B0, 1, 0); PG8_LDB(B1, 1, 1); PG8_SCHED; PG8_LDA(At, 1, 0); PG8_STAGE(PG8_SA(0, 1), a2 + hstep, voffA);
            PG8_WAIT_V(8); PG8_WAIT_L(0); PG8_BAR; PG8_MMA(0, 0, At, B0); PG8_MMA(0, 1, At, B1); PG8_BAR; PG8_SCHED;
            PG8_LDA(At, 1, 1); PG8_STAGE(PG8_SB(1, 0), b3, voffB); PG8_STAGE(PG8_SB(1, 1), b3 + hstep, voffB); PG8_STAGE(PG8_SA(1, 0), a3, voffA);
            PG8_WAIT_V(8); PG8_WAIT_L(0); PG8_BAR; PG8_MMA(1, 0, At, B0); PG8_MMA(1, 1, At, B1); PG8_BAR; PG8_SCHED;
            } else {
            PG8_LDB(B0, 0, 0); PG8_SCHED; PG8_LDA(At, 0, 0); PG8_STAGE(PG8_SA(1, 1), a1 + hstep, voffA);
            PG8_WAIT_L(8); PG8_BAR; PG8_WAIT_L(0); PG8_MMA(0, 0, At, B0); PG8_BAR; PG8_SCHED;
            PG8_LDB(B1, 0, 1); PG8_STAGE(PG8_SB(0, 0), b2, voffB);
            PG8_BAR; PG8_WAIT_L(0); PG8_MMA(0, 1, At, B1); PG8_BAR;
            PG8_LDA(At, 0, 1); PG8_STAGE(PG8_SA(0, 0), a2, voffA);
            PG8_BAR; PG8_WAIT_L(0); PG8_MMA(1, 0, At, B0); PG8_BAR; PG8_SCHED;
            PG8_STAGE(PG8_SB(0, 1), b2 + hstep, voffB);
            PG8_WAIT_V(6); PG8_BAR; PG8_MMA(1, 1, At, B1); PG8_BAR;
            PG8_LDB(B0, 1, 0); PG8_SCHED; PG8_LDA(At, 1, 0); PG8_STAGE(PG8_SA(0, 1), a2 + hstep, voffA);
            PG8_WAIT_L(8); PG8_BAR; PG8_WAIT_L(0); PG8_MMA(0, 0, At, B0); PG8_BAR; PG8_SCHED;
            PG8_LDB(B1, 1, 1); PG8_STAGE(PG8_SB(1, 0), b3, voffB);
            PG8_BAR; PG8_WAIT_L(0); PG8_MMA(0, 1, At, B1); PG8_BAR;
            PG8_LDA(At, 1, 1); PG8_STAGE(PG8_SA(1, 0), a3, voffA);
            PG8_BAR; PG8_WAIT_L(0); PG8_MMA(1, 0, At, B0); PG8_BAR; PG8_SCHED;
            PG8_STAGE(PG8_SB(1, 1), b3 + hstep, voffB);
            PG8_WAIT_V(6); PG8_BAR; PG8_MMA(1, 1, At, B1); PG8_BAR;
            }
        }
        if constexpr (ALIGN_EPI) { if (wr == 0) PG8_BAR; }
        if constexpr (!Epi::AFTER_DRAIN) { E(acc, cur, wr, wc, fr, fq); S.done(cur); }
        if (!has_next) break;
#pragma unroll
        for (int a = 0; a < 2; ++a)
#pragma unroll
            for (int b = 0; b < 2; ++b)
#pragma unroll
                for (int m = 0; m < 4; ++m)
#pragma unroll
                    for (int n = 0; n < 2; ++n) acc[a][b][m][n] = (f32x4){0.f, 0.f, 0.f, 0.f};
        cur = nxt; cA = nA; cB = nB; ++ui;
        if constexpr (ALIGN_EPI) { if (wr == 1) PG8_BAR; }
    }
    PG8_WAIT_V(0);
    if constexpr (!ALIGN_EPI) { if (wr == 0) PG8_BAR; }
    PG8_BAR;
    if constexpr (Epi::AFTER_DRAIN) { E.fused(acc, cur, wr, wc, fr, fq, lds, wid, lane); S.done(cur); }
#undef PG8_SA
#undef PG8_SB
#undef PG8_STAGE
#undef PG8_LDA
#undef PG8_LDB
#undef PG8_MMA
#undef PG8_WAIT_V
#undef PG8_WAIT_L
#undef PG8_BAR
#undef PG8_SCHED
}
}

#define DI __device__ __forceinline__
typedef unsigned short u16;
typedef short bf16x8 __attribute__((ext_vector_type(8)));
typedef short s16x4 __attribute__((ext_vector_type(4)));
typedef float f32x4 __attribute__((ext_vector_type(4)));
typedef float f32x16 __attribute__((ext_vector_type(16)));
typedef unsigned u32x4 __attribute__((ext_vector_type(4)));
typedef unsigned u32x2 __attribute__((ext_vector_type(2)));

constexpr int T = 16384, DM = 1024, FF = 2816, SEQ = 2048, NB = 8;
constexpr int ZW = 2560;
constexpr size_t MiB = 1u << 20;
constexpr size_t OFF_WFFN = 0;
constexpr size_t SZ_WGU = (size_t)5632 * 1024 * 2, SZ_WD = (size_t)1024 * 2816 * 2, SZ_WFFN = SZ_WGU + SZ_WD;
constexpr size_t OFF_WEVIN = 132 * MiB, OFF_WEVOUT = 142 * MiB, OFF_WODIN = 146 * MiB, OFF_WODOUT = 150 * MiB, OFF_WGLU = 154 * MiB;
constexpr size_t OFF_BT1 = 156 * MiB, OFF_FMAT = 172 * MiB, OFF_XB = 180 * MiB, OFF_SS = 212 * MiB, OFF_ROPE = 213 * MiB, OFF_MISC = 214 * MiB;
constexpr size_t OFF_BAR = OFF_MISC + 512 * 1024;
constexpr size_t OFF_UN = 215 * MiB;
constexpr size_t OFF_ACT = OFF_UN, OFF_Z = OFF_UN, OFF_KSR = OFF_UN + 80 * MiB, OFF_KWR = OFF_UN + 84 * MiB, OFF_VST = OFF_UN + 88 * MiB, OFF_VWT = OFF_UN + 92 * MiB;
constexpr size_t OFF_KC = OFF_UN + 96 * MiB, OFF_VCT = OFF_KC + 512 * 1024, OFF_CAT = OFF_UN + 98 * MiB;
constexpr size_t OFF_UD = OFF_UN, OFF_YIN = OFF_UN + 16 * MiB, OFF_E = OFF_UN + 48 * MiB, OFF_ZC = OFF_UN + 64 * MiB;
constexpr size_t OFF_YG = OFF_UN + 80 * MiB;
constexpr size_t OFF_XL = OFF_UN + 130 * MiB;
constexpr size_t OFF_WB16 = OFF_ROPE + 512 * 1024;
constexpr size_t OFF_W1T = OFF_UN + 97 * MiB;
constexpr size_t WS_NEED = OFF_UN + 130 * MiB;
static_assert(8 * SZ_WFFN <= 132 * MiB, "ffn weights");
constexpr int LDS_BYTES = 147456;

struct Prm { const float* in[26]; float* out; unsigned char* ws; };

DI void st16_wt(void* p, u32x4 v) { asm volatile("global_store_dwordx4 %0, %1, off sc1\n\ts_nop 1" :: "v"(p), "v"(v) : "memory"); }
DI void st16f_wt(void* p, f32x4 v) { asm volatile("global_store_dwordx4 %0, %1, off sc1\n\ts_nop 1" :: "v"(p), "v"(v) : "memory"); }
DI void st8_wt(void* p, u32x2 v) { asm volatile("global_store_dwordx2 %0, %1, off sc1\n\ts_nop 1" :: "v"(p), "v"(v) : "memory"); }
DI void st16_pl(void* p, u32x4 v) { *(u32x4*)p = v; }
DI void st16_nt(void* p, u32x4 v) { __builtin_nontemporal_store(v, (u32x4*)p); }
DI void st8_pl(void* p, u32x2 v) { *(u32x2*)p = v; }
DI void st16f_pl(void* p, f32x4 v) { *(f32x4*)p = v; }
DI float bf2f(unsigned v) { return __uint_as_float(v << 16); }
DI unsigned cvtpk(float lo, float hi) { typedef float f2 __attribute__((ext_vector_type(2))); typedef __bf16 b2 __attribute__((ext_vector_type(2))); f2 v = {lo, hi}; b2 b = __builtin_convertvector(v, b2); return __builtin_bit_cast(unsigned, b); }
DI void unpack8(const u32x4 w, float* f) { f[0] = __uint_as_float(w.x << 16); f[1] = __uint_as_float(w.x & 0xffff0000u); f[2] = __uint_as_float(w.y << 16); f[3] = __uint_as_float(w.y & 0xffff0000u);
    f[4] = __uint_as_float(w.z << 16); f[5] = __uint_as_float(w.z & 0xffff0000u); f[6] = __uint_as_float(w.w << 16); f[7] = __uint_as_float(w.w & 0xffff0000u); }
DI u32x4 pack8(const float* f) { u32x4 w; w.x = cvtpk(f[0], f[1]); w.y = cvtpk(f[2], f[3]); w.z = cvtpk(f[4], f[5]); w.w = cvtpk(f[6], f[7]); return w; }
DI float gelu_t(float x) { const float u = 1.5957691216f * (x + 0.044715f * x * x * x); return x * __builtin_amdgcn_rcpf(1.f + __expf(-u)); }
DI float sigm(float x) { return __builtin_amdgcn_rcpf(1.f + __expf(-x)); }
DI float row_rstd(const float* SS, int row) { const f32x4* p = (const f32x4*)(SS + (size_t)row * 16); const f32x4 a = p[0], b = p[1], c = p[2], d = p[3];
    const float s = ((a.x + a.y) + (a.z + a.w)) + ((b.x + b.y) + (b.z + b.w)) + ((c.x + c.y) + (c.z + c.w)) + ((d.x + d.y) + (d.z + d.w)); return rsqrtf(s * (1.f / 1024.f) + 1e-6f); }

using pg8::Unit;
typedef pg8::f32x4 pf4;
template <int MODE> struct EpiGated {
    static constexpr bool PERM = true, AFTER_DRAIN = false;
    u16* O; int ldc; int col_off; const float* SS;
    DI void operator()(const pf4 (&acc)[2][2][4][2], const Unit& u, int wr, int wc, int fr, int fq) const {
#pragma unroll
        for (int ai = 0; ai < 2; ++ai)
#pragma unroll
            for (int m = 0; m < 4; ++m) {
                const int row = u.pm * 256 + ai * 128 + wr * 64 + m * 16 + fr;
                float o[8];
                if (MODE == 0) { const float rs = row_rstd(SS, row);
#pragma unroll
                    for (int n = 0; n < 2; ++n)
#pragma unroll
                        for (int j = 0; j < 4; ++j) { const float g = acc[ai][0][m][n][j] * rs, uu = acc[ai][1][m][n][j] * rs; o[n * 4 + j] = g * sigm(g) * uu; }
                } else {
#pragma unroll
                    for (int n = 0; n < 2; ++n)
#pragma unroll
                        for (int j = 0; j < 4; ++j) { const float a = acc[ai][0][m][n][j], b = acc[ai][1][m][n][j]; o[n * 4 + j] = a * sigm(b); }
                }
                st16_nt(O + (size_t)row * ldc + col_off + u.pn * 128 + wc * 32 + 8 * fq, pack8(o));
            }
    }
};
struct EpiResid {
    static constexpr bool PERM = true, AFTER_DRAIN = false;
    u16* XB; float* SS; float scale;
    DI void operator()(const pf4 (&acc)[2][2][4][2], const Unit& u, int wr, int wc, int fr, int fq) const {
#pragma unroll
        for (int ai = 0; ai < 2; ++ai)
#pragma unroll
            for (int m = 0; m < 4; ++m) {
                const int row = u.pm * 256 + ai * 128 + wr * 64 + m * 16 + fr;
                float sq = 0.f;
#pragma unroll
                for (int bj = 0; bj < 2; ++bj) {
                    const int col = u.pn * 256 + bj * 128 + wc * 32 + 8 * fq;
                    const size_t off = (size_t)row * 1024 + col;
                    float hi[8], o[8], h2[8];
                    unpack8(*(const u32x4*)(XB + off), hi);
#pragma unroll
                    for (int j = 0; j < 4; ++j) { o[j] = hi[j] + scale * acc[ai][bj][m][0][j]; o[4 + j] = hi[4 + j] + scale * acc[ai][bj][m][1][j]; }
                    const u32x4 hp = pack8(o); unpack8(hp, h2);
#pragma unroll
                    for (int j = 0; j < 8; ++j) sq += h2[j] * h2[j];
                    st16_nt(XB + off, hp);
                }
                sq += __shfl_xor(sq, 16); sq += __shfl_xor(sq, 32);
                if (fq == 0) SS[(size_t)row * 16 + u.pn * 4 + wc] = sq;
            }
    }
};
struct EpiEvIn {
    static constexpr bool PERM = true, AFTER_DRAIN = false;
    u16* Z; const float* SS;
    DI void operator()(const pf4 (&acc)[2][2][4][2], const Unit& u, int wr, int wc, int fr, int fq) const {
#pragma unroll
        for (int ai = 0; ai < 2; ++ai)
#pragma unroll
            for (int m = 0; m < 4; ++m) {
                const int row = u.pm * 256 + ai * 128 + wr * 64 + m * 16 + fr; const float rs = row_rstd(SS, row);
#pragma unroll
                for (int bj = 0; bj < 2; ++bj) { float o[8];
#pragma unroll
                    for (int j = 0; j < 4; ++j) { o[j] = acc[ai][bj][m][0][j] * rs; o[4 + j] = acc[ai][bj][m][1][j] * rs; }
                    st16_nt(Z + (size_t)row * ZW + u.pn * 256 + bj * 128 + wc * 32 + 8 * fq, pack8(o)); }
            }
    }
};
struct EpiOdIn {
    static constexpr bool PERM = true, AFTER_DRAIN = false;
    u16* ZC; u16* UD; const float* SS;
    DI void operator()(const pf4 (&acc)[2][2][4][2], const Unit& u, int wr, int wc, int fr, int fq) const {
#pragma unroll
        for (int ai = 0; ai < 2; ++ai)
#pragma unroll
            for (int m = 0; m < 4; ++m) {
                const int row = u.pm * 256 + ai * 128 + wr * 64 + m * 16 + fr; const float rs = row_rstd(SS, row);
#pragma unroll
                for (int bj = 0; bj < 2; ++bj) { float o[8];
#pragma unroll
                    for (int j = 0; j < 4; ++j) { o[j] = acc[ai][bj][m][0][j] * rs; o[4 + j] = acc[ai][bj][m][1][j] * rs; }
                    const int col = u.pn * 256 + bj * 128 + wc * 32 + 8 * fq;
                    if (u.pn < 2) st16_pl(ZC + (size_t)row * 512 + col, pack8(o));
                    else { const int c2 = col - 512, g = c2 >> 4, ci = c2 & 15; st16_pl(UD + ((size_t)(g * 1024 + (row >> 4)) * 256 + (row & 15) * 16 + ci), pack8(o)); } }
            }
    }
};
struct EpiS5A {
    static constexpr bool PERM = true, AFTER_DRAIN = false;
    float* YIN; float* E;
    DI void operator()(const pf4 (&acc)[2][2][4][2], const Unit& u, int wr, int wc, int fr_, int fq_) const {
        int fr = fr_, fq = fq_; asm volatile("" : "+v"(fr), "+v"(fq));
        const int g = u.pm >> 2, pml = u.pm & 3, pnl = u.pn & 1;
        float* base = pnl == 0 ? YIN + (size_t)g * 1024 * 256 : E + (size_t)g * 1024 * 128; const int ld = pnl == 0 ? 256 : 128; const int nbj = pnl == 0 ? 2 : 1;
#pragma unroll
        for (int ai = 0; ai < 2; ++ai)
#pragma unroll
            for (int m = 0; m < 4; ++m) {
                const int rowl = pml * 256 + ai * 128 + wr * 64 + m * 16 + fr;
#pragma unroll
                for (int bj = 0; bj < 2; ++bj) if (bj < nbj) { float* p = base + (size_t)rowl * ld + bj * 128 + wc * 32 + 8 * fq; st16f_pl(p, acc[ai][bj][m][0]); st16f_pl(p + 4, acc[ai][bj][m][1]); }
            }
    }
};
struct EpiS5B {
    static constexpr bool PERM = true, AFTER_DRAIN = false;
    const float* YIN; u16* YG;
    DI void operator()(const pf4 (&acc)[2][2][4][2], const Unit& u, int wr, int wc, int fr, int fq) const {
        const int g = u.pm >> 2, pml = u.pm & 3;
#pragma unroll
        for (int ai = 0; ai < 2; ++ai)
#pragma unroll
            for (int m = 0; m < 4; ++m) {
                const int rowl = pml * 256 + ai * 128 + wr * 64 + m * 16 + fr;
#pragma unroll
                for (int bj = 0; bj < 2; ++bj) { const int col = bj * 128 + wc * 32 + 8 * fq;
                    const float* yp = YIN + (size_t)(g * 1024 + rowl) * 256 + col; const f32x4 a = *(const f32x4*)yp, b = *(const f32x4*)(yp + 4); float o[8];
#pragma unroll
                    for (int j = 0; j < 4; ++j) { o[j] = gelu_t(a[j] + acc[ai][bj][m][0][j]); o[4 + j] = gelu_t(b[j] + acc[ai][bj][m][1][j]); }
                    const int token = rowl * 16 + (col >> 4);
                    st16_pl(YG + (size_t)token * 512 + g * 16 + (col & 15), pack8(o)); }
            }
    }
};
struct S5FA { int L;
    DI bool next(int i, Unit& u) const { if (i >= 2) return false; u.pm = L; u.pn = (L >> 2) * 2 + i; return true; }
    DI void a_ready(const Unit&) const {} DI void done(const Unit&) const {} };
struct S5FB { int L;
    DI bool next(int i, Unit& u) const { if (i >= 1) return false; u.pm = L; u.pn = L >> 2; return true; }
    DI void a_ready(const Unit&) const {} DI void done(const Unit&) const {} };
struct S5AOrder { int G, c;
    DI bool next(int i, Unit& u) const { const int L = i * G + c; if (L >= 256) return false; const int g = L >> 3, r = L & 7; u.pm = g * 4 + (r >> 1); u.pn = g * 2 + (r & 1); return true; }
    DI void a_ready(const Unit&) const {} DI void done(const Unit&) const {} };
struct S5BOrder { int G, c;
    DI bool next(int i, Unit& u) const { const int L = i * G + c; if (L >= 128) return false; u.pm = L; u.pn = L >> 2; return true; }
    DI void a_ready(const Unit&) const {} DI void done(const Unit&) const {} };

struct TJob { const float* W; int ldw, K, N, Nvalid; const float* gain; u16* dst; int blk, stride, off; };

DI void tile_writeout(const TJob& J, const float* tile, int k0, int n0) {
    const int tid = otid(), n = tid >> 3, kc = (tid & 7) * 8;
    float v[8];
#pragma unroll
    for (int j = 0; j < 8; ++j) v[j] = tile[(kc + j) * 65 + n];
    const int nn = n0 + n; const int drow = (nn / J.blk) * J.stride + (nn % J.blk) + J.off;
    st16_pl(J.dst + (size_t)drow * J.K + k0 + kc, pack8(v));
}
DI void tjob_run(const TJob& J, float* tile, int vb, int G) {
    const int tid = otid(), tk = J.K / 64, tn = J.N / 64, nt = tk * tn;
    const int kk = tid >> 4, nn = (tid & 15) * 4;
    for (int it0 = vb; it0 < nt; it0 += 8 * G) {
        f32x4 v[8][2];
#pragma unroll
        for (int q = 0; q < 8; ++q) { const int it = it0 + q * G; const int k0 = (it % tk) * 64, n0 = (it / tk) * 64;
#pragma unroll
            for (int i = 0; i < 2; ++i) { v[q][i] = (f32x4){0.f, 0.f, 0.f, 0.f};
                if (it < nt && n0 + nn < J.Nvalid) v[q][i] = __builtin_nontemporal_load((const f32x4*)(J.W + (size_t)(k0 + kk + 32 * i) * J.ldw + n0 + nn)); } }
#pragma unroll
        for (int q = 0; q < 8; ++q) { const int it = it0 + q * G; const int k0 = (it % tk) * 64;
#pragma unroll
            for (int i = 0; i < 2; ++i) { const float gn = (J.gain && it < nt) ? J.gain[k0 + kk + 32 * i] : 1.f; float* tp = tile + q * (64 * 65) + (kk + 32 * i) * 65 + nn;
                tp[0] = v[q][i].x * gn; tp[1] = v[q][i].y * gn; tp[2] = v[q][i].z * gn; tp[3] = v[q][i].w * gn; } }
        __syncthreads();
#pragma unroll
        for (int q = 0; q < 8; ++q) { const int it = it0 + q * G; if (it < nt) tile_writeout(J, tile + q * (64 * 65), (it % tk) * 64, (it / tk) * 64); }
        __syncthreads();
    }
}
DI void pool_fold_run(const float* Win, const float* Wp, const float* scale, const float* gain, u16* dst, float* tile, int vb, int G) {
    const int tid = otid(); TJob J{nullptr, 0, 1024, 512, 512, nullptr, dst, 512, 0, 0};
    for (int it = vb; it < 16 * 8; it += G) {
        const int k0 = (it & 15) * 64, n0 = (it >> 4) * 64, grp = n0 >> 7, n = tid & 63, kq = tid >> 6;
        float acc[8];
#pragma unroll
        for (int j = 0; j < 8; ++j) acc[j] = 0.f;
        const float* wp = Wp + (size_t)grp * 128 * 128 + ((n0 & 127) + n);
        for (int c = 0; c < 128; ++c) { const float w = wp[(size_t)c * 128];
#pragma unroll
            for (int j = 0; j < 8; ++j) acc[j] += Win[(size_t)(k0 + kq * 8 + j) * 1024 + grp * 128 + c] * w; }
        const float sc = scale[n0 + n];
#pragma unroll
        for (int j = 0; j < 8; ++j) tile[(kq * 8 + j) * 65 + n] = acc[j] * sc * gain[k0 + kq * 8 + j];
        __syncthreads();
        tile_writeout(J, tile, k0, n0);
        __syncthreads();
    }
}

DI void s5_tables_item(const Prm& P, int i, int g, float* lds) {
    float* BB = lds;
    float* CC = lds + 2048;
    float* PW = lds + 4096;
    float* KL = lds + 6400;
    const int tid = otid(), ig = i * 32 + g;
    u16* BT1 = (u16*)(P.ws + OFF_BT1) + (size_t)ig * 512 * 256;
    u16* FM = (u16*)(P.ws + OFF_FMAT) + (size_t)ig * 256 * 256;
    float* LAML = (float*)(P.ws + OFF_MISC) + 4096 + (size_t)ig * 128;
    if (tid < 64) { const int p = tid;
        const float lr0 = P.in[17][ig * 64 + p], li0 = P.in[18][ig * 64 + p], dt = __expf(P.in[24][ig]);
        const float a = lr0 * dt, bb = li0 * dt * 0.15915494309189535f;
        for (int tau = 0; tau <= 16; ++tau) { const float mag = __expf(a * tau); float rev = bb * tau; rev -= rintf(rev); const float ang = rev * 6.283185307179586f;
            PW[(tau * 64 + p) * 2] = mag * cosf(ang); PW[(tau * 64 + p) * 2 + 1] = mag * sinf(ang); }
        const float nr = PW[(64 + p) * 2] - 1.f, ni = PW[(64 + p) * 2 + 1], den = 1.f / (lr0 * lr0 + li0 * li0);
        const float cr = (nr * lr0 + ni * li0) * den, ci_ = (ni * lr0 - nr * li0) * den;
        for (int ci = 0; ci < 16; ++ci) { const float br = P.in[19][(ig * 64 + p) * 16 + ci], bi = P.in[20][(ig * 64 + p) * 16 + ci];
            BB[(p * 16 + ci) * 2] = cr * br - ci_ * bi; BB[(p * 16 + ci) * 2 + 1] = cr * bi + ci_ * br; }
        LAML[p * 2] = PW[(16 * 64 + p) * 2]; LAML[p * 2 + 1] = PW[(16 * 64 + p) * 2 + 1];
    }
    for (int e = tid; e < 1024; e += 512) { CC[e * 2] = P.in[21][ig * 1024 + e]; CC[e * 2 + 1] = P.in[22][ig * 1024 + e]; }
    __syncthreads();
    for (int e = tid; e < 4096; e += 512) { const int tau = e >> 8, co = (e >> 4) & 15, ci = e & 15; float s = 0.f;
        for (int p = 0; p < 64; ++p) { const float c_r = CC[(co * 64 + p) * 2], c_i = CC[(co * 64 + p) * 2 + 1], w_r = PW[(tau * 64 + p) * 2], w_i = PW[(tau * 64 + p) * 2 + 1];
            const float x_r = c_r * w_r - c_i * w_i, x_i = c_r * w_i + c_i * w_r; s += x_r * BB[(p * 16 + ci) * 2] - x_i * BB[(p * 16 + ci) * 2 + 1]; }
        if (tau == 0 && co == ci) s += P.in[23][ig * 16 + co];
        KL[e] = s; }
    __syncthreads();
    for (int q = tid; q < 256 * 32; q += 512) { const int row = q >> 5, cc = (q & 31) * 8, t = row >> 4, co = row & 15, s = cc >> 4, ci0 = cc & 15, tau = t - s; float v[8];
#pragma unroll
        for (int j = 0; j < 8; ++j) v[j] = tau >= 0 ? KL[(tau * 16 + co) * 16 + ci0 + j] : 0.f;
        *(u32x4*)(BT1 + (size_t)row * 256 + cc) = pack8(v); }
    for (int q = tid; q < 256 * 32; q += 512) { const int row2 = q >> 5, cc = (q & 31) * 8; float v[8];
        if (row2 < 128) { const int c = row2 >> 6, p = row2 & 63, s = cc >> 4, ci0 = cc & 15; const float w_r = PW[((15 - s) * 64 + p) * 2], w_i = PW[((15 - s) * 64 + p) * 2 + 1];
#pragma unroll
            for (int j = 0; j < 8; ++j) { const float b_r = BB[(p * 16 + ci0 + j) * 2], b_i = BB[(p * 16 + ci0 + j) * 2 + 1]; v[j] = c ? (w_r * b_i + w_i * b_r) : (w_r * b_r - w_i * b_i); }
        } else {
#pragma unroll
            for (int j = 0; j < 8; ++j) v[j] = 0.f; }
        *(u32x4*)(BT1 + (size_t)(256 + row2) * 256 + cc) = pack8(v); }
    for (int q = tid; q < 256 * 32; q += 512) { const int row = q >> 5, cc = (q & 31) * 8, t = row >> 4, co = row & 15; float v[8];
#pragma unroll
        for (int j = 0; j < 8; ++j) { const int k = cc + j; if (k < 128) { const int p = k & 63; const float c_r = CC[(co * 64 + p) * 2], c_i = CC[(co * 64 + p) * 2 + 1], w_r = PW[((t + 1) * 64 + p) * 2], w_i = PW[((t + 1) * 64 + p) * 2 + 1];
                v[j] = (k < 64) ? (c_r * w_r - c_i * w_i) : -(c_r * w_i + c_i * w_r); } else v[j] = 0.f; }
        *(u32x4*)(FM + (size_t)row * 256 + cc) = pack8(v); }
    __syncthreads();
}

DI void convert_layer_part(const Prm& P, int l, int part, int vb, int G, float* tile) {
    unsigned char* ws = P.ws; const int lj = l * 2 + part, i = l >> 1;
    { const float* gain = P.in[1] + (size_t)(l * 3 + (part ? 2 : 0)) * 1024;
      u16* gu = (u16*)(ws + OFF_WFFN + (size_t)lj * SZ_WFFN); u16* dn = (u16*)(ws + OFF_WFFN + (size_t)lj * SZ_WFFN + SZ_WGU);
      TJob a{P.in[2] + (size_t)lj * 1024 * FF, FF, 1024, FF, FF, gain, gu, 128, 256, 0}; tjob_run(a, tile, vb, G);
      TJob b{P.in[3] + (size_t)lj * 1024 * FF, FF, 1024, FF, FF, gain, gu, 128, 256, 128}; tjob_run(b, tile, vb, G);
      TJob c{P.in[4] + (size_t)lj * FF * 1024, 1024, FF, 1024, 1024, nullptr, dn, 1024, 0, 0}; tjob_run(c, tile, vb, G); }
    const float* g_mx = P.in[1] + (size_t)(l * 3 + 1) * 1024;
    if (!(l & 1)) {
        if (part == 0) { TJob a{P.in[6] + (size_t)i * 1024 * 2328, 2328, 1024, ZW, 2328, g_mx, (u16*)(ws + OFF_WEVIN) + (size_t)i * ZW * 1024, ZW, 0, 0}; tjob_run(a, tile, vb, G); }
        else { TJob b{P.in[7] + (size_t)i * 1024 * 1024, 1024, 1024, 1024, 1024, nullptr, (u16*)(ws + OFF_WEVOUT) + (size_t)i * 1024 * 1024, 1024, 0, 0}; tjob_run(b, tile, vb, G); }
    } else {
        u16* odin = (u16*)(ws + OFF_WODIN) + (size_t)i * 1024 * 1024;
        if (part == 0) { TJob c{P.in[13] + (size_t)i * 1024 * 1024 + 512, 1024, 1024, 512, 512, g_mx, odin + (size_t)512 * 1024, 512, 0, 0}; tjob_run(c, tile, vb, G);
            pool_fold_run(P.in[13] + (size_t)i * 1024 * 1024, P.in[15] + (size_t)i * 4 * 128 * 128, P.in[16] + i * 512, g_mx, odin, tile, vb, G); }
        else { TJob d{P.in[14] + (size_t)i * 1024 * 1024, 1024, 1024, 1024, 1024, nullptr, (u16*)(ws + OFF_WODOUT) + (size_t)i * 1024 * 1024, 1024, 0, 0}; tjob_run(d, tile, vb, G);
            u16* glu = (u16*)(ws + OFF_WGLU) + (size_t)i * 1024 * 512;
            TJob e{P.in[25] + (size_t)i * 512 * 1024, 1024, 512, 512, 512, nullptr, glu, 128, 256, 0}; tjob_run(e, tile, vb, G);
            TJob f{P.in[25] + (size_t)i * 512 * 1024 + 512, 1024, 512, 512, 512, nullptr, glu, 128, 256, 128}; tjob_run(f, tile, vb, G); }
    }
}
DI void phase_prep(const Prm& P, unsigned char* ldsb) {
    float* tile = (float*)ldsb; const int tid = otid(), lane = tid & 63, wave = tid >> 6;
    unsigned char* ws = P.ws;
    for (int ll = 0; ll < 4; ++ll) { convert_layer_part(P, ll, 0, obid(), ogdim(), tile); convert_layer_part(P, ll, 1, obid(), ogdim(), tile); }
    { u16* WB = (u16*)(ws + OFF_WB16);
      for (int e = (obid() * 512 + tid) * 2; e < 2 * 8 * 128 * 128; e += ogdim() * 1024) { const int t = (e >> 7) & 127, s = e & 127; const float a = P.in[8][e], b2 = P.in[8][e + 1];
          *(unsigned*)(WB + e) = cvtpk(s <= t ? a : 0.f, (s + 1) <= t ? b2 : 0.f); } }
    for (int it = 0; it < 4; ++it) { TJob a{P.in[11] + (size_t)it * 2048 * 64, 64, 2048, 64, 64, nullptr, (u16*)(ws + OFF_W1T) + (size_t)it * 64 * 2048, 64, 0, 0}; tjob_run(a, tile, obid(), ogdim()); }
    for (int it = obid(); it < 64; it += ogdim()) s5_tables_item(P, it >> 5, it & 31, tile);
    for (int it = obid(); it < 4; it += ogdim()) {
        const float* pe = P.in[10] + (size_t)it * 2048; const float* w1 = P.in[11] + (size_t)it * 2048 * 64; const int j = tid & 63, part = tid >> 6; float s = 0.f;
        for (int k = part * 256; k < part * 256 + 256; ++k) s += pe[k] * w1[(size_t)k * 64 + j];
        tile[part * 64 + j] = s; __syncthreads();
        if (tid < 64) { float t2 = 0.f; for (int q = 0; q < 8; ++q) t2 += tile[q * 64 + tid]; ((float*)(ws + OFF_MISC))[it * 64 + tid] = t2; }
        __syncthreads();
    }
    { float* COS = (float*)(ws + OFF_ROPE); float* SIN = COS + 2048 * 32;
      for (int e = obid() * 512 + tid; e < 2048 * 32; e += ogdim() * 512) { const int t = e >> 5, i = e & 31; const float inv = exp2f(-(float)i * (13.287712379549449f / 32.f)); const float ang = (float)t * inv; COS[e] = cosf(ang); SIN[e] = sinf(ang); } }
    { const float* x = P.in[0]; u16* XB = (u16*)(ws + OFF_XB); float* SS = (float*)(ws + OFF_SS);
      for (int row = obid() * 8 + wave; row < T; row += ogdim() * 8) { float sq = 0.f;
#pragma unroll
          for (int i = 0; i < 2; ++i) { const int col = lane * 8 + 512 * i; const size_t off = (size_t)row * 1024 + col; float v[8], h2[8];
              const f32x4 a = *(const f32x4*)(x + off), b2 = *(const f32x4*)(x + off + 4);
              v[0] = a.x; v[1] = a.y; v[2] = a.z; v[3] = a.w; v[4] = b2.x; v[5] = b2.y; v[6] = b2.z; v[7] = b2.w;
              const u32x4 hp = pack8(v); unpack8(hp, h2);
#pragma unroll
              for (int j = 0; j < 8; ++j) sq += h2[j] * h2[j];
              st16_pl(XB + off, hp); }
#pragma unroll
          for (int o = 32; o >= 1; o >>= 1) sq += __shfl_xor(sq, o);
          if (lane < 16) SS[(size_t)row * 16 + lane] = lane == 0 ? sq : 0.f; } }
}

#define MFMA32E(a, b, c) __builtin_amdgcn_mfma_f32_32x32x16_bf16((a), (b), (c), 0, 0, 0)
DI void gmlp_item(const Prm& P, int i, int item, unsigned char* ldsb) {
    u16* VT = (u16*)ldsb;
    const int tid = otid(), h = item & 7, bc = item >> 3, token0 = bc * 128;
    const u16* Z = (const u16*)(P.ws + OFF_Z); u16* CAT = (u16*)(P.ws + OFF_CAT);
    { const int tok = tid >> 2, part = tid & 3; const u16* vp = Z + (size_t)(token0 + tok) * ZW + 512 + h * 64 + part * 16;
      float v[16]; unpack8(*(const u32x4*)vp, v); unpack8(*(const u32x4*)(vp + 8), v + 8);
      float s = 0.f;
#pragma unroll
      for (int j = 0; j < 16; ++j) { v[j] = gelu_t(v[j]); s += v[j]; }
      s += __shfl_xor(s, 1); s += __shfl_xor(s, 2); const float mu = s * (1.f / 64.f); float q = 0.f;
#pragma unroll
      for (int j = 0; j < 16; ++j) { v[j] -= mu; q += v[j] * v[j]; }
      q += __shfl_xor(q, 1); q += __shfl_xor(q, 2); const float rs = rsqrtf(q * (1.f / 64.f) + 1e-5f);
#pragma unroll
      for (int j = 0; j < 16; j += 2) { const unsigned w = cvtpk(v[j] * rs, v[j + 1] * rs); VT[(part * 16 + j) * 136 + tok] = (u16)(w & 0xffffu); VT[(part * 16 + j + 1) * 136 + tok] = (u16)(w >> 16); } }
    __syncthreads();
    { const int wv = tid >> 6, lane = tid & 63, r = lane & 31, hh = lane >> 5, db = wv & 1, tb = wv >> 1;
      const u16* WB = (const u16*)(P.ws + OFF_WB16) + ((size_t)(i * 8 + h) * 128 + 32 * tb + r) * 128 + 8 * hh;
      const u16* va = VT + (32 * db + r) * 136 + 8 * hh;
      f32x16 acc;
#pragma unroll
      for (int e = 0; e < 16; ++e) acc[e] = 0.f;
#pragma unroll
      for (int ks = 0; ks < 8; ++ks) if (ks <= 2 * tb + 1) { const bf16x8 a = *(const bf16x8*)(va + 16 * ks); const bf16x8 b2 = *(const bf16x8*)(WB + 16 * ks); acc = MFMA32E(a, b2, acc); }
      const int t = 32 * tb + r, token = token0 + t; const float bias = P.in[9][(i * 8 + h) * 128 + t];
#pragma unroll
      for (int gi = 0; gi < 4; ++gi) { const int d0 = 32 * db + 8 * gi + 4 * hh; const u32x2 uu = *(const u32x2*)(Z + (size_t)token * ZW + h * 64 + d0);
          const float u0 = gelu_t(bf2f(uu.x & 0xffffu)) * (acc[gi * 4] + bias), u1 = gelu_t(bf2f(uu.x >> 16)) * (acc[gi * 4 + 1] + bias), u2 = gelu_t(bf2f(uu.y & 0xffffu)) * (acc[gi * 4 + 2] + bias), u3 = gelu_t(bf2f(uu.y >> 16)) * (acc[gi * 4 + 3] + bias);
          u32x2 o; o.x = cvtpk(u0, u1); o.y = cvtpk(u2, u3); st8_pl(CAT + (size_t)token * 1024 + h * 64 + d0, o); } }
    __syncthreads();
}
DI void cmp_item(const Prm& P, int i, int item, float* lds) {
    float* PART = lds;
    float* HB = lds + 8 * 32 * 64;
    float* OB = HB + 32 * 64;
    const int tid = otid(), wv = tid >> 6, lane = tid & 63, r = lane & 31, hh = lane >> 5;
    const int nt = item & 3, g = (item >> 2) & 1, b = (item >> 3) & 7, kv = item >> 6;
    const u16* Z = (const u16*)(P.ws + OFF_Z);
    const int col0 = (kv ? 1664 : 1536) + g * 64, n_a = nt * 32 + r;
    const u16* w1t = (const u16*)(P.ws + OFF_W1T) + (size_t)(i * 2 + kv) * 64 * 2048;
    f32x16 acc0, acc1;
#pragma unroll
    for (int e = 0; e < 16; ++e) { acc0[e] = 0.f; acc1[e] = 0.f; }
#pragma unroll 4
    for (int q = 0; q < 16; ++q) { const int ks = wv * 16 + q, l = ks >> 2, d = 16 * (ks & 3) + 8 * hh, pos = 16 * n_a + l;
        bf16x8 a = (bf16x8){0, 0, 0, 0, 0, 0, 0, 0};
        if (n_a < 127 && pos < SEQ) a = *(const bf16x8*)(Z + (size_t)(b * SEQ + pos) * ZW + col0 + d);
        const bf16x8 b0 = *(const bf16x8*)(w1t + (size_t)r * 2048 + 16 * ks + 8 * hh), b1 = *(const bf16x8*)(w1t + (size_t)(32 + r) * 2048 + 16 * ks + 8 * hh);
        acc0 = MFMA32E(a, b0, acc0); acc1 = MFMA32E(a, b1, acc1); }
#pragma unroll
    for (int e = 0; e < 16; ++e) { const int nl = (e & 3) + 8 * (e >> 2) + 4 * hh; PART[(wv * 32 + nl) * 64 + r] = acc0[e]; PART[(wv * 32 + nl) * 64 + 32 + r] = acc1[e]; }
    __syncthreads();
    const int j = tid & 63, nq = tid >> 6;
    { const float cpe = ((const float*)(P.ws + OFF_MISC))[(i * 2 + kv) * 64 + j];
#pragma unroll
      for (int u = 0; u < 4; ++u) { const int nl = nq * 4 + u; float s = cpe;
#pragma unroll
          for (int w = 0; w < 8; ++w) s += PART[(w * 32 + nl) * 64 + j];
          HB[nl * 64 + j] = gelu_t(s); } }
    __syncthreads();
    { const float* w2 = P.in[12] + (size_t)(i * 2 + kv) * 64 * 64 + j; float o[4] = {0.f, 0.f, 0.f, 0.f};
#pragma unroll 8
      for (int k = 0; k < 64; ++k) { const float w = w2[k * 64];
#pragma unroll
          for (int u = 0; u < 4; ++u) o[u] += HB[(nq * 4 + u) * 64 + k] * w; }
#pragma unroll
      for (int u = 0; u < 4; ++u) OB[(nq * 4 + u) * 64 + j] = o[u]; }
    __syncthreads();
#pragma unroll
    for (int u = 0; u < 4; ++u) { const int nl = nq * 4 + u, n = nt * 32 + nl;
        if (kv == 0) { u16* KC = (u16*)(P.ws + OFF_KC) + (size_t)(b * 2 + g) * 128 * 64; float val = 0.f;
            if (n < 127) { const int pos = n * 16 + 31; const float* COS = (const float*)(P.ws + OFF_ROPE); const float* SIN = COS + 2048 * 32; const int d = j & 31; const float cs = COS[pos * 32 + d], sn = SIN[pos * 32 + d];
                const float x1 = OB[nl * 64 + d], x2 = OB[nl * 64 + 32 + d]; val = (j < 32) ? (x1 * cs - x2 * sn) : (x2 * cs + x1 * sn); }
            KC[(size_t)n * 64 + j] = (u16)(cvtpk(val, 0.f) & 0xffffu);
        } else { u16* VCT = (u16*)(P.ws + OFF_VCT) + (size_t)(b * 2 + g) * 64 * 128; VCT[(size_t)j * 128 + n] = (u16)(cvtpk(n < 127 ? OB[nl * 64 + j] : 0.f, 0.f) & 0xffffu); } }
    __syncthreads();
}
DI void rope_item(const Prm& P, int item, unsigned char* ldsb) {
    const int tid = otid(), b = item >> 5, tt = item & 31, token0 = b * SEQ + tt * 64;
    u16* Z = (u16*)(P.ws + OFF_Z); const float* COS = (const float*)(P.ws + OFF_ROPE); const float* SIN = COS + 2048 * 32;
    const float SC = 0.125f * 1.4426950408889634f;
#pragma unroll 1
    for (int q = 0; q < 4; ++q) { const int e = tid + 512 * q, tok = e >> 5, hh = (e >> 2) & 7, c = e & 3, d0 = c * 8, pos = tt * 64 + tok;
        u16* p = Z + (size_t)(token0 + tok) * ZW + 1024 + hh * 64 + d0; float a[8], bq[8], o1[8], o2[8]; unpack8(*(const u32x4*)p, a); unpack8(*(const u32x4*)(p + 32), bq);
#pragma unroll
        for (int j = 0; j < 8; ++j) { const float cs = COS[pos * 32 + d0 + j], sn = SIN[pos * 32 + d0 + j]; o1[j] = (a[j] * cs - bq[j] * sn) * SC; o2[j] = (bq[j] * cs + a[j] * sn) * SC; }
        st16_pl(p, pack8(o1)); st16_pl(p + 32, pack8(o2)); }
#pragma unroll 1
    for (int q = 0; q < 2; ++q) { const int e = tid + 512 * q, tok = e >> 4, which = (e >> 2) & 3, ten = which >> 1, g = which & 1, c = e & 3, d0 = c * 8, pos = tt * 64 + tok;
        const u16* p = Z + (size_t)(token0 + tok) * ZW + (ten ? 2048 : 1792) + g * 64 + d0; float a[8], bq[8], o1[8], o2[8]; unpack8(*(const u32x4*)p, a); unpack8(*(const u32x4*)(p + 32), bq);
#pragma unroll
        for (int j = 0; j < 8; ++j) { const float cs = COS[pos * 32 + d0 + j], sn = SIN[pos * 32 + d0 + j]; o1[j] = a[j] * cs - bq[j] * sn; o2[j] = bq[j] * cs + a[j] * sn; }
        u16* dst = (u16*)(P.ws + (ten ? OFF_KWR : OFF_KSR)) + ((size_t)(b * 2 + g) * SEQ + pos) * 64 + d0; st16_pl(dst, pack8(o1)); st16_pl(dst + 32, pack8(o2)); }
    u16* TL = (u16*)ldsb;
#pragma unroll 1
    for (int q = 0; q < 4; ++q) { const int ten = q >> 1, g = q & 1, tok = tid >> 3, c = tid & 7;
        *(u32x4*)(TL + (q * 64 + tok) * 72 + c * 8) = *(const u32x4*)(Z + (size_t)(token0 + tok) * ZW + (ten ? 2176 : 1920) + g * 64 + c * 8); }
    __syncthreads();
#pragma unroll 1
    for (int q = 0; q < 4; ++q) { const int ten = q >> 1, g = q & 1, d = tid >> 3, tc = tid & 7; unsigned w[4];
#pragma unroll
        for (int j = 0; j < 4; ++j) { const unsigned lo = TL[(q * 64 + tc * 8 + 2 * j) * 72 + d], hi = TL[(q * 64 + tc * 8 + 2 * j + 1) * 72 + d]; w[j] = lo | (hi << 16); }
        u16* dst = (u16*)(P.ws + (ten ? OFF_VWT : OFF_VST)) + ((size_t)(b * 2 + g) * 64 + d) * SEQ + tt * 64 + tc * 8; st16_pl(dst, (u32x4){w[0], w[1], w[2], w[3]}); }
    __syncthreads();
}

#define MFMA32(a, b, c) __builtin_amdgcn_mfma_f32_32x32x16_bf16((a), (b), (c), 0, 0, 0)
constexpr int AT_KB = 9216, AT_VB = 8704;
constexpr int AT_OFF_V = 2 * AT_KB, AT_OFF_IMPA = AT_OFF_V + 2 * AT_VB, AT_IMP_SZ = 4 * 64 * 33 * 4, AT_OFF_IMPB = AT_OFF_IMPA + AT_IMP_SZ, AT_OFF_IMPS = AT_OFF_IMPB + AT_IMP_SZ, AT_OFF_SELM = AT_OFF_IMPS + 64 * 33 * 4;
static_assert(AT_OFF_SELM + 256 <= 131072, "attention lds");

struct AttTile { u32x4 k, v; };
DI AttTile att_gload(const u16* Kb, const u16* Vt, int vstride, int j) { const int tid = otid(), row = tid >> 3, c = tid & 7; AttTile t;
    t.k = *(const u32x4*)(Kb + ((size_t)(j * 64 + row) * 64 + c * 8)); t.v = *(const u32x4*)(Vt + ((size_t)row * vstride + j * 64 + c * 8)); return t; }
DI void att_lstore(unsigned char* lds, int buf, const AttTile& t) { const int tid = otid(), row = tid >> 3, c = tid & 7;
    *(u32x4*)(lds + buf * AT_KB + row * 144 + c * 16) = t.k;
    u32x2* vp = (u32x2*)(lds + AT_OFF_V + buf * AT_VB + row * 136 + c * 16); vp[0] = (u32x2){t.v.x, t.v.y}; vp[1] = (u32x2){t.v.z, t.v.w}; }
DI void att_qk(const unsigned char* lds, int buf, const bf16x8 (&qf)[4], int r, int h, f32x16& s0, f32x16& s1) {
    const unsigned char* kb = lds + buf * AT_KB + r * 144 + h * 16;
#pragma unroll
    for (int i = 0; i < 16; ++i) { s0[i] = 0.f; s1[i] = 0.f; }
#pragma unroll
    for (int ks = 0; ks < 4; ++ks) { const bf16x8 k0 = *(const bf16x8*)(kb + ks * 32), k1 = *(const bf16x8*)(kb + 32 * 144 + ks * 32);
        s0 = MFMA32(k0, qf[ks], s0); s1 = MFMA32(k1, qf[ks], s1); }
}
DI bf16x8 att_pack(const f32x16& p, int s) { u32x4 w; w.x = cvtpk(p[8 * s], p[8 * s + 1]); w.y = cvtpk(p[8 * s + 2], p[8 * s + 3]); w.z = cvtpk(p[8 * s + 4], p[8 * s + 5]); w.w = cvtpk(p[8 * s + 6], p[8 * s + 7]); return __builtin_bit_cast(bf16x8, w); }
template <bool GENERAL>
DI void att_step(const unsigned char* lds, int buf, const bf16x8 (&qf)[4], int r, int h, int kbase, int lo, int hi, bool lanevalid, float& m, float& l, f32x16& o0, f32x16& o1) {
    f32x16 s0, s1; att_qk(lds, buf, qf, r, h, s0, s1);
    float mx = -1e30f;
    if (GENERAL) {
#pragma unroll
        for (int i = 0; i < 16; ++i) { const int k0 = kbase + (i & 3) + 8 * (i >> 2) + 4 * h, k1 = k0 + 32; const bool v0 = (k0 >= lo) && (k0 <= hi), v1 = (k1 >= lo) && (k1 <= hi);
            s0[i] = v0 ? s0[i] : -1e30f; s1[i] = v1 ? s1[i] : -1e30f; mx = fmaxf(mx, fmaxf(s0[i], s1[i])); }
    } else {
#pragma unroll
        for (int i = 0; i < 16; ++i) mx = fmaxf(mx, fmaxf(s0[i], s1[i]));
        mx = lanevalid ? mx : -1e30f;
    }
    mx = fmaxf(mx, __shfl_xor(mx, 32));
    const float mn = fmaxf(m, mx), alpha = __builtin_amdgcn_exp2f(m - mn); m = mn;
    float ps = 0.f;
    if (GENERAL) {
#pragma unroll
        for (int i = 0; i < 16; ++i) { const float p0 = (s0[i] > -1e29f) ? __builtin_amdgcn_exp2f(s0[i] - mn) : 0.f, p1 = (s1[i] > -1e29f) ? __builtin_amdgcn_exp2f(s1[i] - mn) : 0.f; s0[i] = p0; s1[i] = p1; ps += p0 + p1; }
    } else {
        const float sub = lanevalid ? mn : __builtin_inff();
#pragma unroll
        for (int i = 0; i < 16; ++i) { const float p0 = __builtin_amdgcn_exp2f(s0[i] - sub), p1 = __builtin_amdgcn_exp2f(s1[i] - sub); s0[i] = p0; s1[i] = p1; ps += p0 + p1; }
    }
    l = l * alpha + ps;
#pragma unroll
    for (int i = 0; i < 16; ++i) { o0[i] *= alpha; o1[i] *= alpha; }
    const unsigned char* vb = lds + AT_OFF_V + buf * AT_VB + r * 136 + h * 8;
#pragma unroll
    for (int kb = 0; kb < 2; ++kb)
#pragma unroll
        for (int s = 0; s < 2; ++s) { const bf16x8 pb = att_pack(kb ? s1 : s0, s);
            const unsigned char* v0p = vb + (32 * kb + 16 * s) * 2;
            const s16x4 a0 = *(const s16x4*)v0p, a1 = *(const s16x4*)(v0p + 16), b0 = *(const s16x4*)(v0p + 32 * 136), b1 = *(const s16x4*)(v0p + 32 * 136 + 16);
            const bf16x8 pa0 = __builtin_shufflevector(a0, a1, 0, 1, 2, 3, 4, 5, 6, 7), pa1 = __builtin_shufflevector(b0, b1, 0, 1, 2, 3, 4, 5, 6, 7);
            o0 = MFMA32(pa0, pb, o0); o1 = MFMA32(pa1, pb, o1); }
}
DI void att_finish(float l, float gate, const f32x16& o0, const f32x16& o1, f32x16& out0, f32x16& out1) {
    const float lt = l + __shfl_xor(l, 32); const float f = lt > 0.f ? gate / lt : 0.f;
#pragma unroll
    for (int i = 0; i < 16; ++i) { out0[i] += f * o0[i]; out1[i] += f * o1[i]; }
}

DI void attn_item(const Prm& P, int item, unsigned char* lds) {
    const int tid = otid(), w = tid >> 6, lane = tid & 63, r = lane & 31, h = lane >> 5;
    const int qt = item >> 4, bg = item & 15, b = bg >> 1, g = bg & 1, hq = w & 3, half = w >> 2;
    const int ql = half * 32 + r, tq = qt * 64 + ql, token = b * SEQ + tq, head = g * 4 + hq;
    const u16* Z = (const u16*)(P.ws + OFF_Z); u16* CAT = (u16*)(P.ws + OFF_CAT);
    bf16x8 qf[4];
#pragma unroll
    for (int ks = 0; ks < 4; ++ks) qf[ks] = *(const bf16x8*)(Z + (size_t)token * ZW + 1024 + head * 64 + ks * 16 + h * 8);
    float gate[3];
#pragma unroll
    for (int c = 0; c < 3; ++c) gate[c] = sigm(bf2f(Z[(size_t)token * ZW + 2304 + head * 3 + c]));
    float* IMPA = (float*)(lds + AT_OFF_IMPA); float* IMPB = (float*)(lds + AT_OFF_IMPB); float* IMPS = (float*)(lds + AT_OFF_IMPS); unsigned* SELM = (unsigned*)(lds + AT_OFF_SELM);
    f32x16 out0, out1, o0, o1;
#pragma unroll
    for (int i = 0; i < 16; ++i) { out0[i] = 0.f; out1[i] = 0.f; o0[i] = 0.f; o1[i] = 0.f; }
    const size_t bgo = (size_t)(b * 2 + g);
    unsigned myselm = 0u, um = 0u;
    const int hic = (tq - 31) >> 4;
#pragma unroll 1
    for (int br = 0; br <= 2; ++br) {
        const u16* Kb; const u16* Vt; int vstride; unsigned tm; int wlo = 0;
        const unsigned causal = (qt >= 31) ? 0xffffffffu : ((2u << qt) - 1u);
        if (br == 0) { Kb = (const u16*)(P.ws + OFF_KC) + bgo * 128 * 64; Vt = (const u16*)(P.ws + OFF_VCT) + bgo * 64 * 128; vstride = 128; tm = 3u; }
        else if (br == 1) { Kb = (const u16*)(P.ws + OFF_KSR) + bgo * SEQ * 64; Vt = (const u16*)(P.ws + OFF_VST) + bgo * 64 * SEQ; vstride = SEQ; tm = um & causal; }
        else { Kb = (const u16*)(P.ws + OFF_KWR) + bgo * SEQ * 64; Vt = (const u16*)(P.ws + OFF_VWT) + bgo * 64 * SEQ; vstride = SEQ; const int jlo = (qt * 64 - 511) > 0 ? ((qt * 64 - 511) >> 6) : 0; tm = causal & ~((1u << jlo) - 1u); wlo = tq - 511; }
#pragma unroll
        for (int i = 0; i < 16; ++i) { o0[i] = 0.f; o1[i] = 0.f; }
        float m = -1e30f, l = 0.f;
        int j = __ffs(tm) - 1; int buf = 0;
        { AttTile t = att_gload(Kb, Vt, vstride, j); att_lstore(lds, 0, t); }
        __syncthreads();
#pragma unroll 1
        while (true) {
            tm &= tm - 1u; const int nj = tm ? (__ffs(tm) - 1) : -1;
            AttTile nt; if (nj >= 0) nt = att_gload(Kb, Vt, vstride, nj);
            const int hi = (br == 0) ? hic : ((br == 1) ? (((myselm >> j) & 1u) ? tq : -1) : tq);
            { const int kb0 = j * 64; const bool full_l = (wlo <= kb0) && (kb0 + 63 <= hi), empty_l = (hi < kb0) || (wlo > kb0 + 63);
              if (__builtin_amdgcn_ballot_w64(!full_l && !empty_l) != 0ull) att_step<true>(lds, buf, qf, r, h, kb0, wlo, hi, full_l, m, l, o0, o1);
              else att_step<false>(lds, buf, qf, r, h, kb0, wlo, hi, full_l, m, l, o0, o1); }
            if (nj >= 0) att_lstore(lds, buf ^ 1, nt);
            __syncthreads();
            if (nj < 0) break;
            j = nj; buf ^= 1;
        }
        att_finish(l, br == 0 ? gate[0] : (br == 1 ? gate[1] : gate[2]), o0, o1, out0, out1);
        if (br == 0) {
            const float lt = l + __shfl_xor(l, 32); const float inv = lt > 0.f ? 1.f / lt : 0.f;
#pragma unroll 1
            for (int jt = 0; jt < 2; ++jt) { f32x16 s0, s1; att_qk(lds, jt, qf, r, h, s0, s1);
#pragma unroll
                for (int kb = 0; kb < 2; ++kb)
#pragma unroll
                    for (int gi = 0; gi < 4; ++gi) { float p[4];
#pragma unroll
                        for (int e = 0; e < 4; ++e) { const int i = gi * 4 + e; const int n = jt * 64 + 32 * kb + 8 * gi + 4 * h + e; const float sv = kb ? s1[i] : s0[i]; p[e] = (n <= hic) ? __builtin_amdgcn_exp2f(sv - m) * inv : 0.f; }
                        const int jp = jt * 16 + 8 * kb + 2 * gi + h;
                        IMPA[(hq * 64 + ql) * 33 + jp] = (p[0] + p[1]) + (p[2] + p[3]);
                        if (jp + 1 < 32) IMPB[(hq * 64 + ql) * 33 + jp + 1] = p[3]; } }
            __syncthreads();
            for (int e = tid; e < 64 * 32; e += 512) { const int q = e >> 5, jj = e & 31; float sacc = 0.f;
#pragma unroll
                for (int hh = 0; hh < 4; ++hh) { sacc += IMPA[(hh * 64 + q) * 33 + jj]; if (jj > 0) sacc += IMPB[(hh * 64 + q) * 33 + jj]; }
                IMPS[q * 33 + jj] = sacc; }
            __syncthreads();
            {
              const int cur = qt, qq = tid >> 3, sub = tid & 7; unsigned mask;
              if (cur <= 7) mask = (2u << cur) - 1u;
              else { mask = 1u | (1u << cur) | (1u << (cur - 1));
                  float v[4];
#pragma unroll
                  for (int e = 0; e < 4; ++e) { const int jj = sub * 4 + e; v[e] = (jj >= 1 && jj <= cur - 2) ? IMPS[qq * 33 + jj] : -1.f; }
#pragma unroll 1
                  for (int rnd = 0; rnd < 5; ++rnd) { float bv = v[0]; int bj = sub * 4;
#pragma unroll
                      for (int e = 1; e < 4; ++e) if (v[e] > bv) { bv = v[e]; bj = sub * 4 + e; }
#pragma unroll
                      for (int o = 1; o <= 4; o <<= 1) { const float ov = __shfl_xor(bv, o); const int oj = __shfl_xor(bj, o); if (ov > bv || (ov == bv && oj < bj)) { bv = ov; bj = oj; } }
                      if (bv >= 0.f) mask |= 1u << bj;
#pragma unroll
                      for (int e = 0; e < 4; ++e) v[e] = (bj == sub * 4 + e) ? -1.f : v[e]; } }
              if (sub == 0) SELM[qq] = mask; }
            __syncthreads();
            myselm = SELM[ql]; um = SELM[lane];
#pragma unroll
            for (int o = 32; o >= 1; o >>= 1) um |= __shfl_xor(um, o);
        }
    }
    u16* op = CAT + (size_t)token * 1024 + 512 + head * 64 + 4 * h;
#pragma unroll
    for (int gi = 0; gi < 4; ++gi) { u32x2 a, c; a.x = cvtpk(out0[gi * 4], out0[gi * 4 + 1]); a.y = cvtpk(out0[gi * 4 + 2], out0[gi * 4 + 3]); c.x = cvtpk(out1[gi * 4], out1[gi * 4 + 1]); c.y = cvtpk(out1[gi * 4 + 2], out1[gi * 4 + 3]);
        st8_pl(op + 8 * gi, a); st8_pl(op + 32 + 8 * gi, c); }
    __syncthreads();
}

DI void s5_scan_task(const Prm& P, int i, int L) {
    const int tid = otid();
    if (tid < 128) { const int g = L >> 2, pml = L & 3, p = tid & 63, b = 2 * pml + (tid >> 6);
        const float* E = (const float*)(P.ws + OFF_E) + (size_t)(g * 1024 + b * 128) * 128; u16* XP = (u16*)(P.ws + OFF_UD) + (size_t)(g * 1024 + b * 128) * 256;
        const float* LAML = (const float*)(P.ws + OFF_MISC) + 4096 + (size_t)(i * 32 + g) * 128; const float lr = LAML[p * 2], li = LAML[p * 2 + 1];
        float xr = 0.f, xi = 0.f;
#pragma unroll 1
        for (int c0 = 0; c0 < 128; c0 += 16) { float er[16], ei[16];
#pragma unroll
            for (int q = 0; q < 16; ++q) { er[q] = E[(size_t)(c0 + q) * 128 + p]; ei[q] = E[(size_t)(c0 + q) * 128 + 64 + p]; }
#pragma unroll
            for (int q = 0; q < 16; ++q) { u16* xp = XP + (size_t)(c0 + q) * 256; xp[p] = (u16)(cvtpk(xr, 0.f) & 0xffffu); xp[64 + p] = (u16)(cvtpk(xi, 0.f) & 0xffffu); xp[128 + p] = 0; xp[192 + p] = 0;
                const float nr = lr * xr - li * xi + er[q], ni = lr * xi + li * xr + ei[q]; xr = nr; xi = ni; } }
    }
}
template <int WLEN> DI void pool_one(const u16* ZC, u16* CAT, int tok, int cc) {
    const int pos = tok & (SEQ - 1); const int cnt = (pos + 1) < WLEN ? (pos + 1) : WLEN;
    u32x4 raw[WLEN];
#pragma unroll
    for (int q = 0; q < WLEN; ++q) { raw[q] = (u32x4){0u, 0u, 0u, 0u}; if (q <= pos) raw[q] = *(const u32x4*)(ZC + (size_t)(tok - q) * 512 + cc * 8); }
    float s[8], z0[8];
    unpack8(raw[0], z0);
#pragma unroll
    for (int j = 0; j < 8; ++j) s[j] = z0[j];
#pragma unroll
    for (int q = 1; q < WLEN; ++q) { float z[8]; unpack8(raw[q], z);
#pragma unroll
        for (int j = 0; j < 8; ++j) s[j] += z[j]; }
    const float ic = __builtin_amdgcn_rcpf((float)cnt);
#pragma unroll
    for (int j = 0; j < 8; ++j) s[j] = s[j] * ic - z0[j];
    st16_pl(CAT + (size_t)tok * 1024 + cc * 8, pack8(s));
}
DI void pool_tasks(const Prm& P, int first) {
    const int tid = otid(); const u16* ZC = (const u16*)(P.ws + OFF_ZC); u16* CAT = (u16*)(P.ws + OFF_CAT); const int nb = ogdim() - first;
    for (int idx = (obid() - first) * 512 + tid; idx < T * 64; idx += nb * 512) { const int grp = (idx >> 6) & 3, tok = ((idx >> 8) << 2) | ((idx >> 4) & 3), cc = grp * 16 + (idx & 15);
        if (grp == 0) pool_one<2>(ZC, CAT, tok, cc); else if (grp == 1) pool_one<4>(ZC, CAT, tok, cc); else if (grp == 2) pool_one<8>(ZC, CAT, tok, cc); else pool_one<16>(ZC, CAT, tok, cc); }
}
DI void phase_final(const Prm& P) {
    const int tid = otid(), lane = tid & 63, wave = tid >> 6; float* X = P.out; const float* SS = (const float*)(P.ws + OFF_SS); const float* gw = P.in[5];
    const u16* XB = (const u16*)(P.ws + OFF_XB);
    for (int row = obid() * 8 + wave; row < T; row += ogdim() * 8) { const float rs = row_rstd(SS, row);
#pragma unroll
        for (int i = 0; i < 2; ++i) { const int col = lane * 8 + 512 * i; const size_t off = (size_t)row * 1024 + col; float hi[8];
            unpack8(*(const u32x4*)(XB + off), hi);
            const f32x4 g0 = *(const f32x4*)(gw + col), g1 = *(const f32x4*)(gw + col + 4);
            f32x4 a, b2;
            a.x = hi[0] * rs * g0.x; a.y = hi[1] * rs * g0.y; a.z = hi[2] * rs * g0.z; a.w = hi[3] * rs * g0.w;
            b2.x = hi[4] * rs * g1.x; b2.y = hi[5] * rs * g1.y; b2.z = hi[6] * rs * g1.z; b2.w = hi[7] * rs * g1.w;
            *(f32x4*)(X + off) = a; *(f32x4*)(X + off + 4) = b2; } }
}

#ifndef REP_MASK
#define REP_MASK 0
#endif
#ifndef REP_TY
#define REP_TY -1
#define REP_N 0
#endif
enum { PH_GU = 0, PH_DOWN, PH_EVIN, PH_E2, PH_ATTN, PH_EVOUT, PH_ODIN, PH_S5A, PH_SCAN, PH_S5B, PH_GLU, PH_ODOUT };
DI int slot_type(int odd, int s) {
    if (!odd) { switch (s) { case 0: return PH_GU; case 1: return PH_DOWN; case 2: return PH_EVIN; case 3: return PH_E2; case 4: return PH_ATTN; case 5: return PH_EVOUT; case 6: return PH_GU; default: return PH_DOWN; } }
    switch (s) { case 0: return PH_GU; case 1: return PH_DOWN; case 2: return PH_ODIN; case 3: return PH_S5A; case 4: return PH_GLU; case 5: return PH_ODOUT; case 6: return PH_GU; default: return PH_DOWN; }
}

typedef const __attribute__((address_space(4))) Prm* KPrm;
DI int opq(int v) { asm volatile("" : "+s"(v)); return v; }
#define XB_TMO      128
#define XB_XCNT(j)  (256  + 64 * (j))
#define XB_XSUB(j)  (1280 + 64 * (j))
#define XB_XGEN(j)  (2304 + 64 * (j))
#define XB_TOP      3328
#define XB_TOPGEN   3392
#define XB_SPIN_CAP (1u << 20)
DI unsigned xb_ld(unsigned* p) { return __hip_atomic_load(p, __ATOMIC_RELAXED, __HIP_MEMORY_SCOPE_AGENT); }
DI unsigned xb_add(unsigned* p, unsigned v) { return __hip_atomic_fetch_add(p, v, __ATOMIC_RELAXED, __HIP_MEMORY_SCOPE_AGENT); }
DI unsigned xb_xcc_id() { return (unsigned)__builtin_amdgcn_s_getreg((3 << 11) | 20) & 0xFu; }
#define XB_SPIN(cond, bar) do { unsigned _sp = 0; while (cond) { __builtin_amdgcn_s_sleep(1); \
    if ((++_sp & 255u) == 0u) { if (xb_ld(&(bar)[XB_TMO])) break; if (_sp > XB_SPIN_CAP) { atomicAdd(&(bar)[XB_TMO], 1u); break; } } } } while (0)
DI void xcd_barrier_complete(unsigned* bar, unsigned x, unsigned& nloc, unsigned& nx) {
    const unsigned G = (unsigned)ogdim();
    unsigned sum, cnt, mine, sp = 0u;
    for (;;) {
        sum = 0u; cnt = 0u; mine = 0u;
#pragma unroll
        for (unsigned j = 0; j < 16; ++j) { const unsigned c = xb_ld(&bar[XB_XCNT(j)]); sum += c; cnt += (c > 0u) ? 1u : 0u; mine = (j == x) ? c : mine; }
        if (sum == G) break;
        __builtin_amdgcn_s_sleep(1);
        if ((++sp & 255u) == 0u) { if (xb_ld(&bar[XB_TMO])) break; if (sp > XB_SPIN_CAP) { atomicAdd(&bar[XB_TMO], 1u); break; } }
    }
    nloc = mine > 0u ? mine : 1u; nx = cnt > 0u ? cnt : 1u;
}
DI void grid_barrier(unsigned* bar, volatile PG8_LAS unsigned* st) {
    asm volatile("s_waitcnt vmcnt(0)" ::: "memory");
    __syncthreads();
    if (otid() == 0) {
        const unsigned x = xb_xcc_id();
        __builtin_amdgcn_s_waitcnt(0);
        unsigned nloc = st[0], nx = st[1];
        if (nloc == 0u) { xcd_barrier_complete(bar, x, nloc, nx); st[0] = nloc; st[1] = nx; }
        const unsigned old = xb_add(&bar[XB_XSUB(x)], 1u);
        const unsigned gen = old / nloc;
        if (old + 1u == (gen + 1u) * nloc) {
            __builtin_amdgcn_fence(__ATOMIC_RELEASE, "agent");
            asm volatile("s_waitcnt vmcnt(0)" ::: "memory");
            const unsigned og = xb_add(&bar[XB_TOP], 1u);
            const unsigned tg = og / nx;
            if (og + 1u == (tg + 1u) * nx) xb_add(&bar[XB_TOPGEN], 1u);
            else XB_SPIN(xb_ld(&bar[XB_TOPGEN]) == tg, bar);
            __builtin_amdgcn_fence(__ATOMIC_ACQUIRE, "agent");
            xb_add(&bar[XB_XGEN(x)], 1u);
            asm volatile("s_waitcnt vmcnt(0)" ::: "memory");
        } else {
            XB_SPIN(xb_ld(&bar[XB_XGEN(x)]) == gen, bar);
            __builtin_amdgcn_fence(__ATOMIC_ACQUIRE, "agent");
            asm volatile("s_waitcnt vmcnt(0)" ::: "memory");
        }
    }
    __syncthreads();
}
DI Prm load_prm(KPrm kp) { Prm P;
#pragma unroll
    for (int i = 0; i < 26; ++i) P.in[i] = kp->in[i];
    P.out = kp->out; P.ws = kp->ws; return P; }
#ifndef GSP2
#define GSP2 true
#endif
__global__ void __launch_bounds__(512, 2) mega_fwd(Prm P_unused, int ph_lo, int ph_hi) {
    extern __shared__ __attribute__((aligned(16))) unsigned char lds[];
    cg::grid_group grid = cg::this_grid();
    PG8_LAS unsigned char* glds = (PG8_LAS unsigned char*)lds;
    int ph = 0;
    { volatile PG8_LAS unsigned* st = (volatile PG8_LAS unsigned*)(glds + 147392); if (otid() < 2) st[otid()] = 0u; __syncthreads();
      KPrm kp0 = (KPrm)__builtin_amdgcn_kernarg_segment_ptr(); unsigned* bar0 = (unsigned*)(kp0->ws + OFF_BAR); if (otid() == 0) (void)xb_add(&bar0[XB_XCNT(xb_xcc_id())], 1u); }
    if (ph_lo < 0) grid.sync();
#define PHASE_BEGIN if (ph >= ph_lo && ph < ph_hi) { KPrm kp = (KPrm)__builtin_amdgcn_kernarg_segment_ptr(); asm volatile("" : "+s"(kp)); const Prm P = load_prm(kp); unsigned char* ws = P.ws; \
    u16* XB = (u16*)(ws + OFF_XB); float* SS = (float*)(ws + OFF_SS); u16* CAT = (u16*)(ws + OFF_CAT); (void)XB; (void)SS; (void)CAT; const int G = ogdim(), c = obid(); (void)G; (void)c;
#define PHASE_END if (ph + 1 < ph_hi) { grid_barrier((unsigned*)(ws + OFF_BAR), (volatile PG8_LAS unsigned*)(glds + 147392)); } } ++ph;
#ifndef SKIP_PREP
#pragma unroll 1
    for (int pass = 0; pass <= ((REP_TY == 98) ? REP_N : 0); ++pass) {
    PHASE_BEGIN for (int rep = 0; rep <= ((REP_TY == 99) ? REP_N : 0); ++rep) phase_prep(P, lds); PHASE_END
#else
    ++ph;
#endif
#pragma unroll 1
    for (int l = 0; l < 4; ++l) { const int odd = l & 1, i = l >> 1, ns = 8;
#pragma unroll 1
        for (int s = 0; s < ns; ++s) {
            PHASE_BEGIN
            const int ty = slot_type(odd, s); const int fj = (s < 2) ? 0 : 1; const int lj = l * 2 + fj;
            const int nrep = (ty == REP_TY || ((REP_MASK >> ty) & 1)) ? REP_N : 0;
#pragma unroll 1
            for (int rep = 0; rep <= nrep; ++rep) {
#ifdef REP_BAR
            if (rep > 0) grid_barrier((unsigned*)(ws + OFF_BAR), (volatile PG8_LAS unsigned*)(glds + 147392));
#endif
#ifndef SKIP_GU
            if (ty == PH_GU) {
                pg8::Gemm gm{XB, (const u16*)(ws + OFF_WFFN + (size_t)lj * SZ_WFFN), T, 5632, opq(1024)}; pg8::StaticOrder S; S.init(T, 5632, G, c);
                EpiGated<0> E{(u16*)(ws + OFF_ACT), FF, 0, SS};
                pg8::gemm_phase<EpiGated<0>, pg8::StaticOrder, true, true>(glds, gm, S, E);
                if (false && c >= 128 && l < 3 && rep == 0) { KPrm kp2 = (KPrm)__builtin_amdgcn_kernarg_segment_ptr(); asm volatile("" : "+s"(kp2)); const Prm P2 = load_prm(kp2); convert_layer_part(P2, l + 1, fj, c - 128, G - 128, (float*)lds); }
            } else
#endif
#ifndef SKIP_GLU
            if (ty == PH_GLU) {
                pg8::Gemm gm{(const u16*)(ws + OFF_YG), (const u16*)(ws + OFF_WGLU) + (size_t)i * 1024 * 512, T, 1024, opq(512)}; pg8::StaticOrder S; S.init(T, 1024, G, c);
                EpiGated<1> E{CAT, 1024, 512, nullptr};
                pg8::gemm_phase<EpiGated<1>, pg8::StaticOrder, true, true>(glds, gm, S, E);
            } else
#endif
#ifndef SKIP_RES
            if (ty == PH_DOWN || ty == PH_EVOUT || ty == PH_ODOUT) {
                const u16* A = (ty == PH_DOWN) ? (const u16*)(ws + OFF_ACT) : CAT;
                const u16* Bt = (ty == PH_DOWN) ? (const u16*)(ws + OFF_WFFN + (size_t)lj * SZ_WFFN + SZ_WGU) : (ty == PH_EVOUT ? (const u16*)(ws + OFF_WEVOUT) + (size_t)i * 1024 * 1024 : (const u16*)(ws + OFF_WODOUT) + (size_t)i * 1024 * 1024);
                pg8::Gemm gm{A, Bt, T, 1024, opq((ty == PH_DOWN) ? FF : 1024)}; pg8::StaticOrder S; S.init(T, 1024, G, c);
                EpiResid E{XB, SS, (rep < nrep) ? 0.f : ((ty == PH_DOWN) ? 0.5f : 1.0f)};
                pg8::gemm_phase<EpiResid, pg8::StaticOrder, true, GSP2>(glds, gm, S, E);
            } else
#endif
#ifndef SKIP_EVIN
            if (ty == PH_EVIN) {
                pg8::Gemm gm{XB, (const u16*)(ws + OFF_WEVIN) + (size_t)i * ZW * 1024, T, ZW, opq(1024)}; pg8::StaticOrder S; S.init(T, ZW, G, c);
                EpiEvIn E{(u16*)(ws + OFF_Z), SS};
                pg8::gemm_phase<EpiEvIn, pg8::StaticOrder, true, GSP2>(glds, gm, S, E);
            } else
#endif
#ifndef SKIP_ODIN
            if (ty == PH_ODIN) {
                pg8::Gemm gm{XB, (const u16*)(ws + OFF_WODIN) + (size_t)i * 1024 * 1024, T, 1024, opq(1024)}; pg8::StaticOrder S; S.init(T, 1024, G, c);
                EpiOdIn E{(u16*)(ws + OFF_ZC), (u16*)(ws + OFF_UD), SS};
                pg8::gemm_phase<EpiOdIn, pg8::StaticOrder, true, GSP2>(glds, gm, S, E);
            } else
#endif
#ifndef SKIP_S5A
            if (ty == PH_S5A) {
                if (c < 128) {
                    { pg8::Gemm gm{(const u16*)(ws + OFF_UD), (const u16*)(ws + OFF_BT1) + (size_t)i * 32 * 512 * 256, 32 * 1024, 32 * 512, opq(256)}; S5FA S{c};
                      EpiS5A E{(float*)(ws + OFF_YIN), (float*)(ws + OFF_E)};
                      pg8::gemm_phase<EpiS5A, S5FA, true, false>(glds, gm, S, E); }
                    asm volatile("s_waitcnt vmcnt(0)" ::: "memory"); __threadfence_block(); __syncthreads();
                    s5_scan_task(P, i, c);
                    asm volatile("s_waitcnt vmcnt(0)" ::: "memory"); __threadfence_block(); __syncthreads();
                    { pg8::Gemm gm{(const u16*)(ws + OFF_UD), (const u16*)(ws + OFF_FMAT) + (size_t)i * 32 * 256 * 256, 32 * 1024, 32 * 256, opq(256)}; S5FB S{c};
                      EpiS5B E{(const float*)(ws + OFF_YIN), (u16*)(ws + OFF_YG)};
                      pg8::gemm_phase<EpiS5B, S5FB, true, false>(glds, gm, S, E); }
                } else pool_tasks(P, 128);
            } else
#endif
#ifndef SKIP_E2
            if (ty == PH_E2) {
                if (G == 256) {
                    if (c < 128) { cmp_item(P, i, c, (float*)lds); if (!rep) rope_item(P, c, lds); }
                    else { if (!rep) rope_item(P, c, lds);
#pragma unroll 1
                        for (int q = 0; q < 4; ++q) gmlp_item(P, i, (c - 128) * 4 + q, lds); }
                } else for (int it = c; it < 1408; it += G) { if (it < 128) cmp_item(P, i, it, (float*)lds); else if (it < 384) { if (!rep) rope_item(P, it - 128, lds); } else gmlp_item(P, i, it - 384, lds); }
            } else
#endif
#ifndef SKIP_ATTN
            if (ty == PH_ATTN) {
                if (G == 256) {
#pragma unroll 1
                    for (int q = 0; q < 2; ++q) gmlp_item(P, i, 512 + c * 2 + q, lds); }
                for (int it = c; it < 256; it += G) {
#pragma unroll 1
                    for (int k2 = 0; k2 < 2; ++k2) attn_item(P, k2 ? 511 - it : it, lds); }
            }
#endif
            {}
            }
            if (REP_TY == 100) { for (int q = 0; q < REP_N; ++q) { grid_barrier((unsigned*)(ws + OFF_BAR), (volatile PG8_LAS unsigned*)(glds + 147392)); } }
            PHASE_END
        }
    }
    }
    PHASE_BEGIN phase_final(P); PHASE_END
}
constexpr int N_PHASES = 1 + 8 + 8 + 8 + 8 + 1;

extern "C" void kernel_launch(void* const* d_in, const int* in_sizes, int n_in, void* d_out, int out_size, void* d_ws, size_t ws_size, hipStream_t stream) {
    static int grid = 0;
    if (grid == 0) {
        if (n_in != 26 || out_size != T * DM || ws_size < WS_NEED) { fprintf(stderr, "kernel_launch: unexpected problem (n_in %d out %d ws %zu need %zu)\n", n_in, out_size, ws_size, (size_t)WS_NEED); grid = -1; return; }
        int dev = 0, cus = 0, per_cu = 0;
        hipGetDevice(&dev); hipDeviceGetAttribute(&cus, hipDeviceAttributeMultiprocessorCount, dev);
        if (hipFuncSetAttribute((const void*)mega_fwd, hipFuncAttributeMaxDynamicSharedMemorySize, LDS_BYTES) != hipSuccess) { fprintf(stderr, "kernel_launch: hipFuncSetAttribute failed\n"); grid = -1; return; }
        hipOccupancyMaxActiveBlocksPerMultiprocessor(&per_cu, (const void*)mega_fwd, 512, LDS_BYTES);
        (void)hipGetLastError();
        if (per_cu < 1) fprintf(stderr, "kernel_launch: occupancy query says %d blocks per CU\n", per_cu);
        grid = cus > 0 ? cus : 256;
    }
    if (grid < 0) return;
    if (hipMemsetAsync((char*)d_ws + OFF_BAR, 0, 16384, stream) != hipSuccess) { fprintf(stderr, "kernel_launch: memset failed\n"); return; }
    Prm p{};
    for (int i = 0; i < 26; ++i) p.in[i] = (const float*)d_in[i];
    p.out = (float*)d_out; p.ws = (unsigned char*)d_ws;
#ifndef MULTI_LAUNCH
    int lo = 0, hi = (REP_TY == 98) ? 100000 : N_PHASES;
    void* args[] = {&p, &lo, &hi};
    hipError_t e = hipLaunchCooperativeKernel((const void*)mega_fwd, dim3(grid), dim3(512), args, LDS_BYTES, stream);
    if (e != hipSuccess) fprintf(stderr, "cooperative launch failed: %s (grid %d)\n", hipGetErrorString(e), grid);
#else
    for (int ph = 0; ph < N_PHASES; ++ph) hipLaunchKernelGGL(mega_fwd, dim3(grid), dim3(512), LDS_BYTES, stream, p, ph, ph + 1);
#endif
}
```
